# Optimizing an MI355X kernel written in HIP

```python
import math
import jax
import jax.numpy as jnp
from jax import lax
import numpy as np

D_MODEL = 1024
BATCH = 4
SEQ = 4096
DEPTH = 2

GRID_W = 64
CTX_LEN = 256
EPS = 1e-6
ROPE_BASE = 10000.0
Q_BLOCK = 128

MLA_HEADS = 8
MLA_Q_RANK = 256
MLA_KV_RANK = 256
MLA_NOPE = 64
MLA_ROPE = 32
MLA_V = 64
MLA_SCALE = (MLA_NOPE + MLA_ROPE) ** -0.5

DIFF_HEADS = 4
DIFF_DH = 64

SWA_HEADS = 8
SWA_KV_HEADS = 2
SWA_DH = 64
WINDOW = 128
SWA_BLOCK = WINDOW

D_FF = -(-8 * D_MODEL // (3 * 256)) * 256

N_BRANCH = 3
BRANCH_A = MLA_HEADS * MLA_V
BRANCH_B = DIFF_HEADS * 2 * DIFF_DH
BRANCH_C = SWA_HEADS * SWA_DH
KV_SPLITS = (MLA_KV_RANK, MLA_ROPE, 2 * DIFF_HEADS * DIFF_DH, DIFF_HEADS * 2 * DIFF_DH,
             SWA_KV_HEADS * SWA_DH, SWA_KV_HEADS * SWA_DH)
Q_SPLITS = (MLA_Q_RANK, 2 * DIFF_HEADS * DIFF_DH, SWA_HEADS * SWA_DH, N_BRANCH * D_MODEL)
KV_WIDTH = sum(KV_SPLITS)
IN_WIDTH = KV_WIDTH + sum(Q_SPLITS)

kernel_name = 'hybrid_mla_diff_swa_prefix_dit'


def rms_norm(x, w):
    xf = x.astype(jnp.float32)
    y = xf * lax.rsqrt(jnp.mean(xf * xf, axis=-1, keepdims=True) + EPS)
    return (y * w.astype(jnp.float32)).astype(x.dtype)


def split_cols(z, widths):
    return jnp.split(z, np.cumsum(widths)[:-1].tolist(), axis=-1)


def axial_rope_tables(rows, rot_dim):
    r = jnp.repeat(jnp.arange(rows, dtype=jnp.float32), GRID_W)
    col = jnp.tile(jnp.arange(GRID_W, dtype=jnp.float32), rows)
    axis_dim = rot_dim // 2
    inv = ROPE_BASE ** (-jnp.arange(0, axis_dim, 2, dtype=jnp.float32) / axis_dim)
    ang_r = r[:, None] * inv
    ang_c = col[:, None] * inv
    return (jnp.cos(ang_r), jnp.sin(ang_r), jnp.cos(ang_c), jnp.sin(ang_c))


def rope_1d(x, cos, sin):
    x1, x2 = jnp.split(x, 2, axis=-1)
    c = cos[None, :, None, :]
    s = sin[None, :, None, :]
    return jnp.concatenate([x1 * c - x2 * s, x2 * c + x1 * s], axis=-1)


def rope_2d(x, tab):
    cr, sr, cc, sc = tab
    d = x.shape[-1]
    out = jnp.concatenate([rope_1d(x[..., : d // 2], cr, sr), rope_1d(x[..., d // 2:], cc, sc)], axis=-1)
    return out.astype(x.dtype)


def adaln(cond, w, b):
    return jnp.split(jax.nn.silu(cond) @ w + b, 6, axis=-1)


def modulate(h, shift, scale):
    return h * (1.0 + scale) + shift


def project_kv(h, w_kv, kv_norm, w_ukv, tabs):
    B, L, _ = h.shape
    ckv, kr, dk, dv, sk, sv = split_cols(h @ w_kv, KV_SPLITS)
    kv = (rms_norm(ckv, kv_norm) @ w_ukv).reshape(B, L, MLA_HEADS, MLA_NOPE + MLA_V)
    kr = kr.reshape(B, L, 1, MLA_ROPE)
    dk = dk.reshape(B, L, 2 * DIFF_HEADS, DIFF_DH)
    sk = sk.reshape(B, L, SWA_KV_HEADS, SWA_DH)
    if tabs is not None:
        kr = rope_2d(kr, tabs[MLA_ROPE])
        dk = rope_2d(dk, tabs[DIFF_DH])
        sk = rope_2d(sk, tabs[SWA_DH])
    return {
        'mla_k': kv[..., :MLA_NOPE], 'mla_v': kv[..., MLA_NOPE:], 'mla_kr': kr[:, :, 0],
        'diff_k': dk, 'diff_v': dv.reshape(B, L, DIFF_HEADS, 2 * DIFF_DH),
        'swa_k': sk, 'swa_v': sv.reshape(B, L, SWA_KV_HEADS, SWA_DH),
    }


def project_q(h, w_q, q_norm, w_uq, tabs):
    B, L, _ = h.shape
    cq, dq, sq, gates = split_cols(h @ w_q, Q_SPLITS)
    q = (rms_norm(cq, q_norm) @ w_uq).reshape(B, L, MLA_HEADS, MLA_NOPE + MLA_ROPE)
    qn, qr = q[..., :MLA_NOPE], q[..., MLA_NOPE:]
    dq = dq.reshape(B, L, 2 * DIFF_HEADS, DIFF_DH)
    sq = sq.reshape(B, L, SWA_HEADS, SWA_DH)
    if tabs is not None:
        qr = rope_2d(qr, tabs[MLA_ROPE])
        dq = rope_2d(dq, tabs[DIFF_DH])
        sq = rope_2d(sq, tabs[SWA_DH])
    return {'mla_qn': qn, 'mla_qr': qr, 'diff_q': dq, 'swa_q': sq, 'gates': jax.nn.sigmoid(gates)}


def sweep_query_blocks(fn, *qs):
    B, S = qs[0].shape[:2]
    nb = S // Q_BLOCK
    blocks = tuple(jnp.moveaxis(q.reshape(B, nb, Q_BLOCK, *q.shape[2:]), 1, 0) for q in qs)
    out = lax.map(lambda blk: fn(*blk), blocks)
    return jnp.moveaxis(out, 0, 1).reshape(B, S, *out.shape[3:])


def mla_attend(qn, qr, kn, kr, v):
    s = (jnp.einsum('bqhd,bkhd->bhqk', qn, kn) + jnp.einsum('bqhr,bkr->bhqk', qr, kr)).astype(jnp.float32)
    p = jax.nn.softmax(s * MLA_SCALE, axis=-1).astype(v.dtype)
    return jnp.einsum('bhqk,bkhd->bqhd', p, v)


def diff_attend(q, k, v, lam):
    B, Lq, H2, dh = q.shape
    s = jnp.einsum('bqhd,bkhd->bhqk', q, k).astype(jnp.float32) * (dh ** -0.5)
    p = jax.nn.softmax(s, axis=-1).reshape(B, H2 // 2, 2, Lq, -1)
    a = (p[:, :, 0] - lam * p[:, :, 1]).astype(v.dtype)
    return jnp.einsum('bhqk,bkhd->bqhd', a, v)


def diff_finish(o, norm_w, lam_init):
    B, L = o.shape[:2]
    return (rms_norm(o, norm_w) * (1.0 - lam_init)).reshape(B, L, BRANCH_B)


def swa_latent(q, k, v, kc, vc, sink):
    B, S, Hq, dh = q.shape
    Hkv = k.shape[2]
    G = Hq // Hkv
    nb = S // SWA_BLOCK
    qb = q.reshape(B, nb, SWA_BLOCK, Hkv, G, dh)

    def band(t):
        tp = jnp.pad(t, ((0, 0), (SWA_BLOCK, SWA_BLOCK), (0, 0), (0, 0)))
        tp = tp.reshape(B, nb + 2, SWA_BLOCK, *t.shape[2:])
        return jnp.concatenate([tp[:, :-2], tp[:, 1:-1], tp[:, 2:]], axis=2)

    kb, vb = band(k), band(v)
    scale = dh ** -0.5
    s_loc = jnp.einsum('bnqhgd,bnkhd->bnhgqk', qb, kb).astype(jnp.float32) * scale
    qpos = jnp.arange(S).reshape(nb, SWA_BLOCK)
    kpos = (jnp.arange(nb)[:, None] - 1) * SWA_BLOCK + jnp.arange(3 * SWA_BLOCK)[None, :]
    kp = kpos[:, None, :]
    mask = (jnp.abs(qpos[:, :, None] - kp) <= WINDOW) & (kp >= 0) & (kp < S)
    s_loc = jnp.where(mask[None, :, None, None], s_loc, -jnp.inf)
    s_ctx = jnp.einsum('bnqhgd,bkhd->bnhgqk', qb, kc).astype(jnp.float32) * scale
    sink_col = jnp.broadcast_to(sink.reshape(Hkv, G)[None, None, :, :, None, None].astype(jnp.float32),
                                s_loc.shape[:-1] + (1,))
    p = jax.nn.softmax(jnp.concatenate([s_loc, s_ctx, sink_col], axis=-1), axis=-1).astype(v.dtype)
    nloc = 3 * SWA_BLOCK
    nctx = kc.shape[1]
    o = (jnp.einsum('bnhgqk,bnkhd->bnqhgd', p[..., :nloc], vb)
         + jnp.einsum('bnhgqk,bkhd->bnqhgd', p[..., nloc:nloc + nctx], vc))
    return o.reshape(B, S, Hq * dh)


def swa_context(q, kc, vc, sink):
    B, C, Hq, dh = q.shape
    Hkv = kc.shape[2]
    G = Hq // Hkv
    qg = q.reshape(B, C, Hkv, G, dh)
    s = jnp.einsum('bqhgd,bkhd->bhgqk', qg, kc).astype(jnp.float32) * (dh ** -0.5)
    sink_col = jnp.broadcast_to(sink.reshape(Hkv, G)[None, :, :, None, None].astype(jnp.float32),
                                s.shape[:-1] + (1,))
    p = jax.nn.softmax(jnp.concatenate([s, sink_col], axis=-1), axis=-1)[..., :-1].astype(vc.dtype)
    return jnp.einsum('bhgqk,bkhd->bqhgd', p, vc).reshape(B, C, Hq * dh)


def latent_branches(qx, kx, kc, lam, lam_init, diff_norm_w, sink):
    B, S = qx['swa_q'].shape[:2]
    cat = lambda n: jnp.concatenate([kc[n], kx[n]], axis=1)
    mk, mkr, mv, dk, dv = cat('mla_k'), cat('mla_kr'), cat('mla_v'), cat('diff_k'), cat('diff_v')
    o_a = sweep_query_blocks(lambda qn, qr: mla_attend(qn, qr, mk, mkr, mv), qx['mla_qn'], qx['mla_qr'])
    o_b = sweep_query_blocks(lambda q: diff_attend(q, dk, dv, lam), qx['diff_q'])
    o_c = swa_latent(qx['swa_q'], kx['swa_k'], kx['swa_v'], kc['swa_k'], kc['swa_v'], sink)
    return o_a.reshape(B, S, BRANCH_A), diff_finish(o_b, diff_norm_w, lam_init), o_c


def context_branches(qc, kc, lam, lam_init, diff_norm_w, sink):
    B, C = qc['swa_q'].shape[:2]
    o_a = mla_attend(qc['mla_qn'], qc['mla_qr'], kc['mla_k'], kc['mla_kr'], kc['mla_v'])
    o_b = diff_attend(qc['diff_q'], kc['diff_k'], kc['diff_v'], lam)
    o_c = swa_context(qc['swa_q'], kc['swa_k'], kc['swa_v'], sink)
    return o_a.reshape(B, C, BRANCH_A), diff_finish(o_b, diff_norm_w, lam_init), o_c


def merge_branches(o_a, o_b, o_c, gates, wa, wb, wc, wo):
    ga, gb, gc = jnp.split(gates, N_BRANCH, axis=-1)
    return (ga * (o_a @ wa) + gb * (o_b @ wb) + gc * (o_c @ wc)) @ wo


def swiglu(h, w_gate_up, w_down):
    g, u = jnp.split(h @ w_gate_up, 2, axis=-1)
    return (jax.nn.silu(g) * u) @ w_down


def setup_inputs(seed: int = 0) -> dict:
    key = jax.random.key(seed)
    ks = iter(jax.random.split(key, 32))
    L, D = DEPTH, D_MODEL

    def nrm(shape, std=1.0):
        return jax.random.normal(next(ks), shape, jnp.float32) * std

    def w(shape, fan_in, gain=1.0):
        return nrm(shape, gain * fan_in ** -0.5)

    def gain_vec(shape):
        return 1.0 + nrm(shape, 0.05)

    return {
        'x': nrm((BATCH, SEQ, D)),
        'c': nrm((BATCH, D)),
        'ctx': nrm((BATCH, CTX_LEN, D)),
        'c_ctx': nrm((D,)),
        'w_ada': w((L, D, 6 * D), D, 0.5),
        'b_ada': nrm((L, 6 * D), 0.05),
        'attn_pre_norm': gain_vec((L, D)),
        'attn_post_norm': gain_vec((L, D)),
        'ffn_pre_norm': gain_vec((L, D)),
        'ffn_post_norm': gain_vec((L, D)),
        'w_in': w((L, D, IN_WIDTH), D),
        'mla_q_norm': gain_vec((L, MLA_Q_RANK)),
        'w_uq': w((L, MLA_Q_RANK, MLA_HEADS * (MLA_NOPE + MLA_ROPE)), MLA_Q_RANK),
        'mla_kv_norm': gain_vec((L, MLA_KV_RANK)),
        'w_ukv': w((L, MLA_KV_RANK, MLA_HEADS * (MLA_NOPE + MLA_V)), MLA_KV_RANK),
        'diff_lambda': nrm((L, 4, DIFF_DH), 0.1),
        'diff_norm': gain_vec((L, 2 * DIFF_DH)),
        'swa_sink': nrm((L, SWA_HEADS), 0.5),
        'w_branch_a': w((L, BRANCH_A, D), BRANCH_A),
        'w_branch_b': w((L, BRANCH_B, D), BRANCH_B),
        'w_branch_c': w((L, BRANCH_C, D), BRANCH_C),
        'w_o': w((L, D, D), D),
        'w_gate_up': w((L, D, 2 * D_FF), D),
        'w_down': w((L, D_FF, D), D_FF),
    }


def reference(x, c, ctx, c_ctx, w_ada, b_ada, attn_pre_norm, attn_post_norm, ffn_pre_norm,
              ffn_post_norm, w_in, mla_q_norm, w_uq, mla_kv_norm, w_ukv, diff_lambda, diff_norm,
              swa_sink, w_branch_a, w_branch_b, w_branch_c, w_o, w_gate_up, w_down):
    S = x.shape[1]
    rows = S // GRID_W
    tabs = {d: axial_rope_tables(rows, d) for d in sorted({MLA_ROPE, DIFF_DH, SWA_DH})}
    for l in range(DEPTH):
        last = l == DEPTH - 1
        lam_init = 0.8 - 0.6 * math.exp(-0.3 * l)
        lq1, lk1, lq2, lk2 = (diff_lambda[l, i].astype(jnp.float32) for i in range(4))
        lam = jnp.exp(jnp.sum(lq1 * lk1)) - jnp.exp(jnp.sum(lq2 * lk2)) + lam_init
        mx = adaln(c[:, None, :], w_ada[l], b_ada[l])
        mc = adaln(c_ctx[None, None, :], w_ada[l], b_ada[l])
        w_kv, w_q = w_in[l][:, :KV_WIDTH], w_in[l][:, KV_WIDTH:]

        hx = modulate(rms_norm(x, attn_pre_norm[l]), mx[0], mx[1])
        hc = modulate(rms_norm(ctx, attn_pre_norm[l]), mc[0], mc[1])
        kx = project_kv(hx, w_kv, mla_kv_norm[l], w_ukv[l], tabs)
        kc = project_kv(hc, w_kv, mla_kv_norm[l], w_ukv[l], None)
        qx = project_q(hx, w_q, mla_q_norm[l], w_uq[l], tabs)
        o_a, o_b, o_c = latent_branches(qx, kx, kc, lam, lam_init, diff_norm[l], swa_sink[l])
        y = merge_branches(o_a, o_b, o_c, qx['gates'], w_branch_a[l], w_branch_b[l], w_branch_c[l], w_o[l])
        x = x + mx[2] * rms_norm(y, attn_post_norm[l])
        if not last:
            qc = project_q(hc, w_q, mla_q_norm[l], w_uq[l], None)
            p_a, p_b, p_c = context_branches(qc, kc, lam, lam_init, diff_norm[l], swa_sink[l])
            yc = merge_branches(p_a, p_b, p_c, qc['gates'], w_branch_a[l], w_branch_b[l], w_branch_c[l], w_o[l])
            ctx = ctx + mc[2] * rms_norm(yc, attn_post_norm[l])

        fx = swiglu(modulate(rms_norm(x, ffn_pre_norm[l]), mx[3], mx[4]), w_gate_up[l], w_down[l])
        x = x + mx[5] * rms_norm(fx, ffn_post_norm[l])
        if not last:
            fc = swiglu(modulate(rms_norm(ctx, ffn_pre_norm[l]), mc[3], mc[4]), w_gate_up[l], w_down[l])
            ctx = ctx + mc[5] * rms_norm(fc, ffn_post_norm[l])
    return x
```

```cpp
#include <hip/hip_runtime.h>
#include <math.h>

namespace nv {
constexpr int D = 1024, B = 4, S = 4096, C = 256, R = C + S;
constexpr int INW = 5920, KVW = 1568, DFF = 2816;
constexpr float EPS = 1e-6f;

__device__ __forceinline__ float siluf(float x) { return x / (1.f + expf(-x)); }
__device__ __forceinline__ float sigmf(float x) { return 1.f / (1.f + expf(-x)); }

__global__ void adaln_k(const float* cond, const float* W, const float* bias, float* out) {
    int n = blockIdx.x * blockDim.x + threadIdx.x; if (n >= 6 * D) return;
    float acc = 0.f;
    for (int k = 0; k < D; ++k) acc += siluf(cond[k]) * W[(size_t)k * 6 * D + n];
    out[n] = acc + bias[n];
}
__global__ void lam_k(const float* dl, float lam_init, float* out) {
    if (threadIdx.x == 0 && blockIdx.x == 0) {
        float a = 0.f, b = 0.f;
        for (int i = 0; i < 64; ++i) { a += dl[i] * dl[64 + i]; b += dl[128 + i] * dl[192 + i]; }
        out[0] = expf(a) - expf(b) + lam_init;
    }
}
__global__ void gather_k(const float* x, const float* ctx, int b, float* xres) {
    size_t i = (size_t)blockIdx.x * blockDim.x + threadIdx.x; if (i >= (size_t)R * D) return;
    int row = (int)(i / D), col = (int)(i % D);
    xres[i] = row < C ? ctx[((size_t)b * C + row) * D + col] : x[((size_t)b * S + (row - C)) * D + col];
}
__device__ __forceinline__ float block_sum(float v, float* red) {
    for (int o = 32; o > 0; o >>= 1) v += __shfl_xor(v, o);
    __syncthreads();
    if ((threadIdx.x & 63) == 0) red[threadIdx.x >> 6] = v;
    __syncthreads();
    float t = 0.f; for (int i = 0; i < (int)(blockDim.x >> 6); ++i) t += red[i];
    return t;
}
__global__ void prenorm_mod_k(const float* xres, const float* w, const float* modx, const float* modc, int si, float* h) {
    __shared__ float red[8];
    int row = blockIdx.x; const float* xr = xres + (size_t)row * D; const float* mod = row < C ? modc : modx;
    float ss = 0.f; for (int j = threadIdx.x; j < D; j += blockDim.x) ss += xr[j] * xr[j];
    ss = block_sum(ss, red);
    float rs = rsqrtf(ss / D + EPS);
    for (int j = threadIdx.x; j < D; j += blockDim.x) h[(size_t)row * D + j] = (xr[j] * rs * w[j]) * (1.f + mod[(si + 1) * D + j]) + mod[si * D + j];
}
__global__ void postnorm_res_k(float* xres, const float* y, const float* w, const float* modx, const float* modc, int gi, int row0) {
    __shared__ float red[8];
    int row = row0 + blockIdx.x; const float* yr = y + (size_t)row * D; const float* mod = row < C ? modc : modx;
    float ss = 0.f; for (int j = threadIdx.x; j < D; j += blockDim.x) ss += yr[j] * yr[j];
    ss = block_sum(ss, red);
    float rs = rsqrtf(ss / D + EPS);
    for (int j = threadIdx.x; j < D; j += blockDim.x) xres[(size_t)row * D + j] += mod[gi * D + j] * (yr[j] * rs * w[j]);
}
__global__ void rms_rows_k(const float* in, int ldi, const float* w, int n, float* out, int ldo, float mul) {
    int row = blockIdx.x; const float* xr = in + (size_t)row * ldi;
    float ss = 0.f; for (int j = threadIdx.x; j < n; j += 64) ss += xr[j] * xr[j];
    for (int o = 32; o > 0; o >>= 1) ss += __shfl_xor(ss, o);
    float rs = rsqrtf(ss / n + EPS);
    for (int j = threadIdx.x; j < n; j += 64) out[(size_t)row * ldo + j] = xr[j] * rs * w[j] * mul;
}
__global__ void __launch_bounds__(256) gemm_k(const float* A, int lda, const float* Bm, int ldb, float* Cm, int ldc, int M, int N, int K) {
    __shared__ float As[16][64 + 1], Bs[16][64 + 1];
    int tx = threadIdx.x & 15, ty = threadIdx.x >> 4; int m0 = blockIdx.y * 64, n0 = blockIdx.x * 64;
    float acc[4][4];
#pragma unroll
    for (int i = 0; i < 4; ++i)
#pragma unroll
        for (int j = 0; j < 4; ++j) acc[i][j] = 0.f;
    for (int k0 = 0; k0 < K; k0 += 16) {
        for (int e = threadIdx.x; e < 64 * 16; e += 256) { int mm = e >> 4, kk = e & 15; As[kk][mm] = A[(size_t)(m0 + mm) * lda + k0 + kk]; }
        for (int e = threadIdx.x; e < 64 * 16; e += 256) { int kk = e >> 6, nn = e & 63; Bs[kk][nn] = (n0 + nn < N) ? Bm[(size_t)(k0 + kk) * ldb + n0 + nn] : 0.f; }
        __syncthreads();
#pragma unroll
        for (int kk = 0; kk < 16; ++kk) {
            float a[4], b[4];
#pragma unroll
            for (int i = 0; i < 4; ++i) { a[i] = As[kk][ty * 4 + i]; b[i] = Bs[kk][tx * 4 + i]; }
#pragma unroll
            for (int i = 0; i < 4; ++i)
#pragma unroll
                for (int j = 0; j < 4; ++j) acc[i][j] += a[i] * b[j];
        }
        __syncthreads();
    }
#pragma unroll
    for (int i = 0; i < 4; ++i)
#pragma unroll
        for (int j = 0; j < 4; ++j) { int n = n0 + tx * 4 + j; if (n < N) Cm[(size_t)(m0 + ty * 4 + i) * ldc + n] = acc[i][j]; }
}
__global__ void rope_k(float* buf, int ld, int col0, int nheads, int hstride, int d) {
    int row = C + blockIdx.x; int t = row - C; int pr = t / 64, pc = t % 64;
    int q = d / 4;
    for (int e = threadIdx.x; e < nheads * 2 * q; e += blockDim.x) {
        int h = e / (2 * q), rem = e % (2 * q), axis = rem / q, i = rem % q;
        float inv = powf(10000.f, -(float)(2 * i) / (float)(d / 2));
        float ang = (float)(axis == 0 ? pr : pc) * inv;
        float cs = cosf(ang), sn = sinf(ang);
        float* p = buf + (size_t)row * ld + col0 + h * hstride + axis * (d / 2);
        float x1 = p[i], x2 = p[i + q];
        p[i] = x1 * cs - x2 * sn; p[i + q] = x2 * cs + x1 * sn;
    }
}
struct AttnArgs {
    const float* q1; int ldq1, hsq1, d1;
    const float* q2; int ldq2, hsq2, d2;
    const float* k1; int ldk1, hsk1, kdiv1;
    const float* k2; int ldk2, hsk2, kdiv2;
    const float* v; int ldv, hsv, vdiv, dv;
    float* o; int ldo, hso;
    float scale; const float* sink;
    int row0, nrows, nheads; int mode;
};
__global__ void __launch_bounds__(64) attn_k(AttnArgs a) {
    __shared__ float sc[R];
    __shared__ float qs[128];
    int qi = blockIdx.x / a.nheads, h = blockIdx.x % a.nheads; int row = a.row0 + qi; int lane = threadIdx.x;
    for (int j = lane; j < a.d1; j += 64) qs[j] = a.q1[(size_t)row * a.ldq1 + h * a.hsq1 + j];
    for (int j = lane; j < a.d2; j += 64) qs[a.d1 + j] = a.q2[(size_t)row * a.ldq2 + h * a.hsq2 + j];
    __syncthreads();
    int nkeys = a.mode == 0 ? C : R; int t = row - C;
    float mx = -INFINITY;
    for (int k = lane; k < nkeys; k += 64) {
        bool ok = true;
        if (a.mode == 2 && k >= C) { int s = k - C; int dlt = t - s; if (dlt < 0) dlt = -dlt; ok = dlt <= 128; }
        float s = -INFINITY;
        if (ok) {
            float acc = 0.f;
            const float* kp = a.k1 + (size_t)k * a.ldk1 + (h / a.kdiv1) * a.hsk1;
            for (int j = 0; j < a.d1; ++j) acc += qs[j] * kp[j];
            if (a.d2) { const float* kp2 = a.k2 + (size_t)k * a.ldk2 + (h / a.kdiv2) * a.hsk2; for (int j = 0; j < a.d2; ++j) acc += qs[a.d1 + j] * kp2[j]; }
            s = acc * a.scale;
        }
        sc[k] = s; mx = fmaxf(mx, s);
    }
    float sk = a.sink ? a.sink[h] : -INFINITY;
    mx = fmaxf(mx, sk);
    for (int o = 32; o > 0; o >>= 1) mx = fmaxf(mx, __shfl_xor(mx, o));
    float sum = 0.f;
    for (int k = lane; k < nkeys; k += 64) { float p = expf(sc[k] - mx); sc[k] = p; sum += p; }
    for (int o = 32; o > 0; o >>= 1) sum += __shfl_xor(sum, o);
    if (a.sink) sum += expf(sk - mx);
    __syncthreads();
    float inv = 1.f / sum;
    for (int j = lane; j < a.dv; j += 64) {
        float acc = 0.f; const float* vp = a.v + (h / a.vdiv) * a.hsv + j;
        for (int k = 0; k < nkeys; ++k) acc += sc[k] * vp[(size_t)k * a.ldv];
        a.o[(size_t)row * a.ldo + h * a.hso + j] = acc * inv;
    }
}
__global__ void __launch_bounds__(128) diff_finish_k(const float* od, const float* lam, float lam_init, const float* w, float* ob, int ldo, int row0) {
    __shared__ float red[8];
    int row = row0 + blockIdx.x / 4, hp = blockIdx.x % 4, j = threadIdx.x;
    float v = od[((size_t)row * 8 + 2 * hp) * 128 + j] - lam[0] * od[((size_t)row * 8 + 2 * hp + 1) * 128 + j];
    float ss = block_sum(v * v, red);
    ob[(size_t)row * ldo + hp * 128 + j] = v * rsqrtf(ss / 128.f + EPS) * w[j] * (1.f - lam_init);
}
__global__ void merge_k(const float* z, const float* pa, const float* pb, const float* pc, float* m, int row0, int nrows) {
    size_t i = (size_t)blockIdx.x * blockDim.x + threadIdx.x; if (i >= (size_t)nrows * D) return;
    int row = row0 + (int)(i / D), j = (int)(i % D); const float* g = z + (size_t)row * INW + 2848; size_t o = (size_t)row * D + j;
    m[o] = sigmf(g[j]) * pa[o] + sigmf(g[D + j]) * pb[o] + sigmf(g[2 * D + j]) * pc[o];
}
__global__ void swiglu_k(const float* gu, float* a, int row0, int nrows) {
    size_t i = (size_t)blockIdx.x * blockDim.x + threadIdx.x; if (i >= (size_t)nrows * DFF) return;
    int row = row0 + (int)(i / DFF), j = (int)(i % DFF);
    a[(size_t)row * DFF + j] = siluf(gu[(size_t)row * 2 * DFF + j]) * gu[(size_t)row * 2 * DFF + DFF + j];
}
__global__ void scatter_out_k(const float* xres, int b, float* out) {
    size_t i = (size_t)blockIdx.x * blockDim.x + threadIdx.x; if (i >= (size_t)S * D) return;
    out[(size_t)b * S * D + i] = xres[(size_t)C * D + i];
}

inline void forward(void* const* d_in, float* d_out, float* ws, hipStream_t st) {
    const float* x = (const float*)d_in[0]; const float* c = (const float*)d_in[1]; const float* ctx = (const float*)d_in[2]; const float* c_ctx = (const float*)d_in[3];
    const float* w_ada = (const float*)d_in[4]; const float* b_ada = (const float*)d_in[5];
    const float* attn_pre = (const float*)d_in[6]; const float* attn_post = (const float*)d_in[7]; const float* ffn_pre = (const float*)d_in[8]; const float* ffn_post = (const float*)d_in[9];
    const float* w_in = (const float*)d_in[10]; const float* q_norm = (const float*)d_in[11]; const float* w_uq = (const float*)d_in[12]; const float* kv_norm = (const float*)d_in[13]; const float* w_ukv = (const float*)d_in[14];
    const float* dlam = (const float*)d_in[15]; const float* dnorm = (const float*)d_in[16]; const float* sink = (const float*)d_in[17];
    const float* wa = (const float*)d_in[18]; const float* wb = (const float*)d_in[19]; const float* wc = (const float*)d_in[20]; const float* wo = (const float*)d_in[21];
    const float* wgu = (const float*)d_in[22]; const float* wdn = (const float*)d_in[23];
    size_t off = 0; auto take = [&](size_t n) { float* p = ws + off; off += (n + 63) / 64 * 64; return p; };
    float* xres = take((size_t)R * D); float* modx = take(6 * D); float* modc = take(6 * D); float* lam = take(64);
    float* h = take((size_t)R * D); float* z = take((size_t)R * INW);
    float* nrm = take((size_t)R * 256); float* kvup = take((size_t)R * 1024); float* qup = take((size_t)R * 768);
    float* oa = take((size_t)R * 512); float* od = take((size_t)R * 1024); float* ob = take((size_t)R * 512); float* oc = take((size_t)R * 512);
    float* pa = take((size_t)R * D); float* pb = od; float* pc = kvup;
    float* act = kvup;
    for (int b = 0; b < B; ++b) {
        gather_k<<<(R * D + 255) / 256, 256, 0, st>>>(x, ctx, b, xres);
        for (int l = 0; l < 2; ++l) {
            const bool last = (l == 1); const float lam_init = 0.8f - 0.6f * expf(-0.3f * (float)l);
            adaln_k<<<6 * D / 256, 256, 0, st>>>(c + (size_t)b * D, w_ada + (size_t)l * D * 6 * D, b_ada + (size_t)l * 6 * D, modx);
            adaln_k<<<6 * D / 256, 256, 0, st>>>(c_ctx, w_ada + (size_t)l * D * 6 * D, b_ada + (size_t)l * 6 * D, modc);
            lam_k<<<1, 64, 0, st>>>(dlam + (size_t)l * 256, lam_init, lam);
            prenorm_mod_k<<<R, 256, 0, st>>>(xres, attn_pre + l * D, modx, modc, 0, h);
            gemm_k<<<dim3((INW + 63) / 64, R / 64), 256, 0, st>>>(h, D, w_in + (size_t)l * D * INW, INW, z, INW, R, INW, D);
            rms_rows_k<<<R, 64, 0, st>>>(z, INW, kv_norm + l * 256, 256, nrm, 256, 1.f);
            gemm_k<<<dim3(1024 / 64, R / 64), 256, 0, st>>>(nrm, 256, w_ukv + (size_t)l * 256 * 1024, 1024, kvup, 1024, R, 1024, 256);
            rms_rows_k<<<R, 64, 0, st>>>(z + 1568, INW, q_norm + l * 256, 256, nrm, 256, 1.f);
            gemm_k<<<dim3(768 / 64, R / 64), 256, 0, st>>>(nrm, 256, w_uq + (size_t)l * 256 * 768, 768, qup, 768, R, 768, 256);
            rope_k<<<S, 64, 0, st>>>(z, INW, 256, 1, 0, 32);
            rope_k<<<S, 256, 0, st>>>(z, INW, 288, 8, 64, 64);
            rope_k<<<S, 64, 0, st>>>(z, INW, 1312, 2, 64, 64);
            rope_k<<<S, 256, 0, st>>>(z, INW, 1824, 8, 64, 64);
            rope_k<<<S, 256, 0, st>>>(z, INW, 2336, 8, 64, 64);
            rope_k<<<S, 128, 0, st>>>(qup, 768, 64, 8, 96, 32);
            for (int pass = 0; pass < 2; ++pass) {
                if (pass == 1 && last) break;
                const int row0 = pass == 0 ? C : 0, nrows = pass == 0 ? S : C;
                AttnArgs A{};
                A.q1 = qup; A.ldq1 = 768; A.hsq1 = 96; A.d1 = 64; A.q2 = qup + 64; A.ldq2 = 768; A.hsq2 = 96; A.d2 = 32;
                A.k1 = kvup; A.ldk1 = 1024; A.hsk1 = 128; A.kdiv1 = 1; A.k2 = z + 256; A.ldk2 = INW; A.hsk2 = 0; A.kdiv2 = 1;
                A.v = kvup + 64; A.ldv = 1024; A.hsv = 128; A.vdiv = 1; A.dv = 64; A.o = oa; A.ldo = 512; A.hso = 64;
                A.scale = 1.f / sqrtf(96.f); A.sink = nullptr; A.row0 = row0; A.nrows = nrows; A.nheads = 8; A.mode = pass == 0 ? 1 : 0;
                attn_k<<<nrows * 8, 64, 0, st>>>(A);
                AttnArgs Dd{};
                Dd.q1 = z + 1824; Dd.ldq1 = INW; Dd.hsq1 = 64; Dd.d1 = 64; Dd.q2 = nullptr; Dd.d2 = 0; Dd.k1 = z + 288; Dd.ldk1 = INW; Dd.hsk1 = 64; Dd.kdiv1 = 1; Dd.k2 = nullptr; Dd.kdiv2 = 1;
                Dd.v = z + 800; Dd.ldv = INW; Dd.hsv = 128; Dd.vdiv = 2; Dd.dv = 128; Dd.o = od; Dd.ldo = 1024; Dd.hso = 128;
                Dd.scale = 0.125f; Dd.sink = nullptr; Dd.row0 = row0; Dd.nrows = nrows; Dd.nheads = 8; Dd.mode = pass == 0 ? 1 : 0;
                attn_k<<<nrows * 8, 64, 0, st>>>(Dd);
                diff_finish_k<<<nrows * 4, 128, 0, st>>>(od, lam, lam_init, dnorm + l * 128, ob, 512, row0);
                AttnArgs W{};
                W.q1 = z + 2336; W.ldq1 = INW; W.hsq1 = 64; W.d1 = 64; W.q2 = nullptr; W.d2 = 0; W.k1 = z + 1312; W.ldk1 = INW; W.hsk1 = 64; W.kdiv1 = 4; W.k2 = nullptr; W.kdiv2 = 1;
                W.v = z + 1440; W.ldv = INW; W.hsv = 64; W.vdiv = 4; W.dv = 64; W.o = oc; W.ldo = 512; W.hso = 64;
                W.scale = 0.125f; W.sink = sink + l * 8; W.row0 = row0; W.nrows = nrows; W.nheads = 8; W.mode = pass == 0 ? 2 : 0;
                attn_k<<<nrows * 8, 64, 0, st>>>(W);
            }
            const int mrow0 = last ? C : 0, mrows = last ? S : R;
            gemm_k<<<dim3(D / 64, mrows / 64), 256, 0, st>>>(oa + (size_t)mrow0 * 512, 512, wa + (size_t)l * 512 * D, D, pa + (size_t)mrow0 * D, D, mrows, D, 512);
            gemm_k<<<dim3(D / 64, mrows / 64), 256, 0, st>>>(ob + (size_t)mrow0 * 512, 512, wb + (size_t)l * 512 * D, D, pb + (size_t)mrow0 * D, D, mrows, D, 512);
            gemm_k<<<dim3(D / 64, mrows / 64), 256, 0, st>>>(oc + (size_t)mrow0 * 512, 512, wc + (size_t)l * 512 * D, D, pc + (size_t)mrow0 * D, D, mrows, D, 512);
            merge_k<<<(mrows * D + 255) / 256, 256, 0, st>>>(z, pa, pb, pc, h, mrow0, mrows);
            gemm_k<<<dim3(D / 64, mrows / 64), 256, 0, st>>>(h + (size_t)mrow0 * D, D, wo + (size_t)l * D * D, D, pa + (size_t)mrow0 * D, D, mrows, D, D);
            postnorm_res_k<<<mrows, 256, 0, st>>>(xres, pa, attn_post + l * D, modx, modc, 2, mrow0);
            prenorm_mod_k<<<R, 256, 0, st>>>(xres, ffn_pre + l * D, modx, modc, 3, h);
            gemm_k<<<dim3(2 * DFF / 64, mrows / 64), 256, 0, st>>>(h + (size_t)mrow0 * D, D, wgu + (size_t)l * D * 2 * DFF, 2 * DFF, z + (size_t)mrow0 * 2 * DFF, 2 * DFF, mrows, 2 * DFF, D);
            swiglu_k<<<(int)(((size_t)mrows * DFF + 255) / 256), 256, 0, st>>>(z, act, mrow0, mrows);
            gemm_k<<<dim3(D / 64, mrows / 64), 256, 0, st>>>(act + (size_t)mrow0 * DFF, DFF, wdn + (size_t)l * DFF * D, D, pa + (size_t)mrow0 * D, D, mrows, D, DFF);
            postnorm_res_k<<<mrows, 256, 0, st>>>(xres, pa, ffn_post + l * D, modx, modc, 5, mrow0);
        }
        scatter_out_k<<<(S * D + 255) / 256, 256, 0, st>>>(xres, b, d_out);
    }
}
}

extern "C" void kernel_launch(void* const* d_in, const int* in_sizes, int n_in, void* d_out, int out_size, void* d_ws, size_t ws_size, hipStream_t stream) {
    nv::forward(d_in, (float*)d_out, (float*)d_ws, stream);
}
```

```cpp
#include <hip/hip_runtime.h>
#include <cstdio>
#include <cstdint>
#include <math.h>
namespace pg8 {
#define PG8_LAS __attribute__((address_space(3)))
typedef unsigned short bf16_t;
typedef short bf16x8 __attribute__((ext_vector_type(8)));
typedef float f32x4 __attribute__((ext_vector_type(4)));
typedef unsigned u32x4 __attribute__((ext_vector_type(4)));
constexpr int BM = 256, BK = 64, HALF = 128, HTB = HALF * BK * 2  , STAGE_BYTES = 8 * HTB, NXCD = 8, WGM = 8;

__host__ __device__ __forceinline__ int lds_byte(int r, int c) { const int st = (r >> 4) * 2 + (c >> 5), rr = r & 15, cc = c & 31, ob = rr * 64 + cc * 2; return st * 1024 + (ob ^ (((ob >> 9) & 1) << 5)); }
__host__ __device__ __forceinline__ void stage_rc(int b, int& R, int& C) { const int st = b / 1024, sb = b % 1024, swz = sb ^ (((sb >> 9) & 1) << 5); R = (st >> 1) * 16 + swz / 64; C = (st & 1) * 32 + (swz % 64) / 2; }
__host__ __device__ __forceinline__ int perm32(int rho) { const int n = rho >> 4, i = rho & 15; return 8 * (i >> 2) + 4 * n + (i & 3); }

struct Unit { int pm, pn, rm, rn, aux; };
struct Gemm { const bf16_t* A; const bf16_t* Bt; int K; };

__device__ __forceinline__ void tile_of(int L, int nM, int nN, int& pm, int& pn) {
    const int nwg = nM * nN; int wgid = L;
    { const int q = nwg / NXCD, r = nwg % NXCD, xcd = wgid % NXCD, off = wgid / NXCD; wgid = (xcd < r ? xcd * (q + 1) : r * (q + 1) + (xcd - r) * q) + off; }
    const int nig = WGM * nN, gid = wgid / nig, fm = gid * WGM, gsz = (nM - fm) < WGM ? (nM - fm) : WGM;
    pm = fm + ((wgid % nig) % gsz); pn = (wgid % nig) / gsz;
}
struct Sched {
    int nMa, nNa, nMb, nNb;
    int pmA, pnA, pmB, pnB;
    int rmB;
    int rep, repM, repN;
    int G, c;
    __device__ __forceinline__ bool next(int i, Unit& u) const {
        const int ti = (rep == 1) ? i : i / rep, br = i - ti * rep;
        const int L = ti * G + c, na = nMa * nNa, nb = nMb * nNb;
        if (L >= na + nb) return false;
        int pm, pn;
        if (L < na) { tile_of(L, nMa, nNa, pm, pn); u.rm = pm; u.rn = pn; u.pm = pmA + pm + br * repM; u.pn = pnA + pn + br * repN; u.aux = br; }
        else { tile_of(L - na, nMb, nNb, pm, pn); u.rm = rmB + pm; u.rn = pn; u.pm = pmB + pm + br * repM; u.pn = pnB + pn + br * repN; u.aux = br | 0x100; }
        return true;
    }
    __device__ __forceinline__ void a_ready(const Unit&) const {}
    __device__ __forceinline__ void done(const Unit&) const {}
};

typedef float f32x2_t __attribute__((ext_vector_type(2))); typedef __bf16 bf16x2_t __attribute__((ext_vector_type(2)));
__device__ __forceinline__ unsigned cvt_pk_bf16(float lo, float hi) { f32x2_t v = {lo, hi}; bf16x2_t b = __builtin_convertvector(v, bf16x2_t); return __builtin_bit_cast(unsigned, b); }
typedef unsigned u32x2 __attribute__((ext_vector_type(2)));

#define PG8_GAS __attribute__((address_space(1)))
__device__ __forceinline__ void gst16(void* p, u32x4 v) { *(PG8_GAS u32x4*)p = v; }
__device__ __forceinline__ void gst8(void* p, unsigned a, unsigned b) { typedef unsigned u2 __attribute__((ext_vector_type(2))); *(PG8_GAS u2*)p = (u2){a, b}; }
__device__ __forceinline__ void gstf4(void* p, f32x4 v) { *(PG8_GAS f32x4*)p = v; }
__device__ __forceinline__ f32x4 gldf4(const void* p) { return *(const PG8_GAS f32x4*)p; }
__device__ __forceinline__ u32x4 gld16(const void* p) { return *(const PG8_GAS u32x4*)p; }
__device__ __forceinline__ float bf_lo(unsigned w) { return __uint_as_float(w << 16); }
__device__ __forceinline__ float bf_hi(unsigned w) { return __uint_as_float(w & 0xffff0000u); }
__device__ __forceinline__ float fast_sigmoid(float x) { return __builtin_amdgcn_rcpf(1.f + __builtin_amdgcn_exp2f(-1.4426950408889634f * x)); }


struct EpiP1 {
    static constexpr bool PERM = false, AFTER_DRAIN = false;
    bf16_t *CKV, *CQ, *KR, *DK, *DV, *SK, *SV, *DQ, *SQ; float *SSKV, *SSQ; const float* TAB; float qscale;
    __device__ __forceinline__ void operator()(const f32x4 (&acc)[2][2][4][2], const Unit& u, int wr, int wc, int fr, int fq) const {
        const bool lat = u.rm < 64;
        const int row0 = u.rm * BM + wr * 64 + fr;
        float ss[2][4];
#pragma unroll
        for (int ai = 0; ai < 2; ++ai)
#pragma unroll
            for (int m = 0; m < 4; ++m) ss[ai][m] = 0.f;
        int kind = 0;
#pragma unroll
        for (int bj = 0; bj < 2; ++bj) {
            const int rn = u.rn;
            const bool isq = rn >= 8;
            bf16_t* dst = (rn == 0) ? CKV : (rn == 1 || rn == 2) ? DK : (rn == 3 || rn == 4) ? DV : (rn == 5) ? (bj ? SV : SK) : (rn == 6) ? KR : (rn == 7) ? CQ : (rn == 8 || rn == 9) ? DQ : SQ;
            const int ld = (rn == 0 || rn == 7) ? 256 : (rn == 5) ? 128 : (rn == 6) ? 32 : 512;
            const int col = (rn == 5 || rn == 6) ? 0 : (((rn == 2 || rn == 4 || rn == 9 || rn == 11) ? 256 : 0) + 128 * bj);
            kind = (rn == 0 || rn == 7) ? 2 : (rn == 3 || rn == 4) ? 0 : (rn == 5) ? (bj ? 0 : 1) : (rn == 6) ? (bj ? 4 : 3) : 1;
            const float scale = isq ? qscale : 1.f;
            if (kind == 4) continue;
            if (kind == 3) {
                if (wc != 0) continue;
#pragma unroll
                for (int ai = 0; ai < 2; ++ai)
#pragma unroll
                    for (int m = 0; m < 4; ++m) {
                        const int row = row0 + ai * HALF + m * 16;
                        f32x4 x0 = acc[ai][bj][m][0], x1 = acc[ai][bj][m][1];
                        if (lat) {
                            f32x4 o0, o1;
#pragma unroll
                            for (int j = 0; j < 4; ++j) { o0[j] = __shfl_xor(x0[j], 32); o1[j] = __shfl_xor(x1[j], 32); }
                            const int pr = (row >> 6) & 63, pc = row & 63, ib = 4 * (fq & 1);
                            const f32x4 cr = gldf4(TAB + 2048 + pr * 8 + ib), sr = gldf4(TAB + 2560 + pr * 8 + ib);
                            const f32x4 cc = gldf4(TAB + 2048 + pc * 8 + ib), sc = gldf4(TAB + 2560 + pc * 8 + ib);
                            if (fq < 2) { x0 = x0 * cr - o0 * sr; x1 = x1 * cc - o1 * sc; } else { x0 = x0 * cr + o0 * sr; x1 = x1 * cc + o1 * sc; }
                        }
                        u32x2 w0, w1; w0.x = cvt_pk_bf16(x0[0], x0[1]); w0.y = cvt_pk_bf16(x0[2], x0[3]); w1.x = cvt_pk_bf16(x1[0], x1[1]); w1.y = cvt_pk_bf16(x1[2], x1[3]);
                        bf16_t* p = dst + (size_t)row * 32 + 4 * fq; gst8(p, w0.x, w0.y); gst8(p + 16, w1.x, w1.y);
                    }
                continue;
            }
            const bool rope = (kind == 1) && lat;
#pragma unroll
            for (int ai = 0; ai < 2; ++ai)
#pragma unroll
                for (int m = 0; m < 4; ++m) {
                    const int row = row0 + ai * HALF + m * 16;
                    f32x4 x0 = acc[ai][bj][m][0], x1 = acc[ai][bj][m][1];
                    if (kind == 2) { ss[ai][m] += (x0[0] * x0[0] + x0[1] * x0[1]) + (x0[2] * x0[2] + x0[3] * x0[3]) + (x1[0] * x1[0] + x1[1] * x1[1]) + (x1[2] * x1[2] + x1[3] * x1[3]); }
                    if (rope) {
                        const int pos = (wc & 1) ? (row & 63) : ((row >> 6) & 63);
                        const f32x4 c4 = gldf4(TAB + pos * 16 + 4 * fq), s4 = gldf4(TAB + 1024 + pos * 16 + 4 * fq);
                        const f32x4 y0 = x0 * c4 - x1 * s4, y1 = x1 * c4 + x0 * s4; x0 = y0; x1 = y1;
                    }
                    x0 = x0 * scale; x1 = x1 * scale;
                    u32x2 w0, w1; w0.x = cvt_pk_bf16(x0[0], x0[1]); w0.y = cvt_pk_bf16(x0[2], x0[3]); w1.x = cvt_pk_bf16(x1[0], x1[1]); w1.y = cvt_pk_bf16(x1[2], x1[3]);
                    bf16_t* p = dst + (size_t)row * ld + col + 32 * wc + 4 * fq; gst8(p, w0.x, w0.y); gst8(p + 16, w1.x, w1.y);
                }
        }
        if (kind == 2) {
            float* S = (u.rn == 0) ? SSKV : SSQ;
#pragma unroll
            for (int ai = 0; ai < 2; ++ai)
#pragma unroll
                for (int m = 0; m < 4; ++m) {
                    float s = ss[ai][m]; s += __shfl_xor(s, 16); s += __shfl_xor(s, 32);
                    if (fq == 0) *(PG8_GAS float*)(S + (size_t)(row0 + ai * HALF + m * 16) * 4 + wc) = s;
                }
        }
    }
};

struct EpiP2 {
    static constexpr bool PERM = true, AFTER_DRAIN = false;
    bf16_t *MK, *MV, *QN, *QR; const float *SSKV, *SSQ; const float* TAB; float qscale; float eps;
    __device__ __forceinline__ void operator()(const f32x4 (&acc)[2][2][4][2], const Unit& u, int wr, int wc, int fr, int fq) const {
        const bool isq = (u.aux & 0x100) != 0, lat = u.rm < 64;
        const int row0 = u.rm * BM + wr * 64 + fr;
        const float* SS = isq ? SSQ : SSKV;
#pragma unroll
        for (int ai = 0; ai < 2; ++ai)
#pragma unroll
            for (int m = 0; m < 4; ++m) {
                const int row = row0 + ai * HALF + m * 16;
                const f32x4 s4 = gldf4(SS + (size_t)row * 4);
                float rs = rsqrtf(((s4[0] + s4[1]) + (s4[2] + s4[3])) * (1.0f / 256.0f) + eps);
                if (isq) rs *= qscale;
#pragma unroll
                for (int bj = 0; bj < 2; ++bj) {
                    f32x4 x0 = acc[ai][bj][m][0] * rs, x1 = acc[ai][bj][m][1] * rs;
                    bf16_t* p;
                    if (!isq) {
                        const int head = 2 * u.rn + bj;
                        p = ((wc < 2) ? MK : MV) + (size_t)row * 512 + head * 64 + (wc & 1) * 32 + 8 * fq;
                    } else {
                        const int g = u.rn * 8 + bj * 4 + wc, head = g / 3, part = g - head * 3;
                        if (part < 2) p = QN + (size_t)row * 512 + head * 64 + part * 32 + 8 * fq;
                        else {
                            p = QR + (size_t)row * 256 + head * 32 + 8 * fq;
                            if (lat) {
                                f32x4 o0, o1;
#pragma unroll
                                for (int j = 0; j < 4; ++j) { o0[j] = __shfl_xor(x0[j], 16); o1[j] = __shfl_xor(x1[j], 16); }
                                const int pos = (fq & 2) ? (row & 63) : ((row >> 6) & 63);
                                const f32x4 c0 = gldf4(TAB + 2048 + pos * 8), c1 = gldf4(TAB + 2048 + pos * 8 + 4);
                                const f32x4 s0 = gldf4(TAB + 2560 + pos * 8), s1 = gldf4(TAB + 2560 + pos * 8 + 4);
                                if ((fq & 1) == 0) { x0 = x0 * c0 - o0 * s0; x1 = x1 * c1 - o1 * s1; } else { x0 = x0 * c0 + o0 * s0; x1 = x1 * c1 + o1 * s1; }
                            }
                        }
                    }
                    u32x4 w; w.x = cvt_pk_bf16(x0[0], x0[1]); w.y = cvt_pk_bf16(x0[2], x0[3]); w.z = cvt_pk_bf16(x1[0], x1[1]); w.w = cvt_pk_bf16(x1[2], x1[3]);
                    gst16(p, w);
                }
            }
    }
};

#ifndef MK_SIG_PERM
#define MK_SIG_PERM true
#endif
struct EpiSig {
    static constexpr bool PERM = MK_SIG_PERM, AFTER_DRAIN = false;
    bf16_t* G;
    __device__ __forceinline__ void operator()(const f32x4 (&acc)[2][2][4][2], const Unit& u, int wr, int wc, int fr, int fq) const {
        const int row0 = u.rm * BM + wr * 64 + fr;
#pragma unroll
        for (int ai = 0; ai < 2; ++ai)
#pragma unroll
            for (int m = 0; m < 4; ++m)
#pragma unroll
                for (int bj = 0; bj < 2; ++bj) {
                    const f32x4 x0 = acc[ai][bj][m][0], x1 = acc[ai][bj][m][1];
                    u32x4 w; w.x = cvt_pk_bf16(fast_sigmoid(x0[0]), fast_sigmoid(x0[1])); w.y = cvt_pk_bf16(fast_sigmoid(x0[2]), fast_sigmoid(x0[3]));
                    w.z = cvt_pk_bf16(fast_sigmoid(x1[0]), fast_sigmoid(x1[1])); w.w = cvt_pk_bf16(fast_sigmoid(x1[2]), fast_sigmoid(x1[3]));
                    bf16_t* rowp = G + (size_t)(row0 + ai * HALF + m * 16) * 3072 + u.rn * BM + bj * HALF + wc * 32;
#ifdef MK_SIG_ST8
                    if (PERM) { gst8(rowp + 8 * fq, w.x, w.y); gst8(rowp + 8 * fq + 4, w.z, w.w); }
#else
                    if (PERM) gst16(rowp + 8 * fq, w);
#endif
                    else { gst8(rowp + 4 * fq, w.x, w.y); gst8(rowp + 16 + 4 * fq, w.z, w.w); }
                }
    }
};

struct EpiMerge {
    static constexpr bool PERM = true, AFTER_DRAIN = false;
    const bf16_t* G; bf16_t* Mb;
    __device__ __forceinline__ void operator()(const f32x4 (&acc)[2][2][4][2], const Unit& u, int wr, int wc, int fr, int fq) const {
        const int br = u.aux & 0xff;
        const int row0 = u.rm * BM + wr * 64 + fr, col0 = u.rn * BM + wc * 32 + 8 * fq;
#pragma unroll
        for (int ai = 0; ai < 2; ++ai)
#pragma unroll
            for (int m = 0; m < 4; ++m)
#pragma unroll
                for (int bj = 0; bj < 2; ++bj) {
                    const size_t row = (size_t)(row0 + ai * HALF + m * 16); const int col = col0 + bj * HALF;
                    const u32x4 g = gld16(G + row * 3072 + br * 1024 + col);
                    bf16_t* mp = Mb + row * 1024 + col;
                    u32x4 mo = (u32x4){0u, 0u, 0u, 0u}; if (br != 0) mo = gld16(mp);
                    const f32x4 x0 = acc[ai][bj][m][0], x1 = acc[ai][bj][m][1];
                    u32x4 w;
                    w.x = cvt_pk_bf16(bf_lo(mo.x) + bf_lo(g.x) * x0[0], bf_hi(mo.x) + bf_hi(g.x) * x0[1]);
                    w.y = cvt_pk_bf16(bf_lo(mo.y) + bf_lo(g.y) * x0[2], bf_hi(mo.y) + bf_hi(g.y) * x0[3]);
                    w.z = cvt_pk_bf16(bf_lo(mo.z) + bf_lo(g.z) * x1[0], bf_hi(mo.z) + bf_hi(g.z) * x1[1]);
                    w.w = cvt_pk_bf16(bf_lo(mo.w) + bf_lo(g.w) * x1[2], bf_hi(mo.w) + bf_hi(g.w) * x1[3]);
                    gst16(mp, w);
                }
        asm volatile("s_waitcnt vmcnt(0)" ::: "memory");
    }
};

struct EpiF32 {
    static constexpr bool PERM = false, AFTER_DRAIN = false;
    float* Y; int ldc;
    __device__ __forceinline__ void operator()(const f32x4 (&acc)[2][2][4][2], const Unit& u, int wr, int wc, int fr, int fq) const {
        const int row0 = u.rm * BM + wr * 64 + fr, col0 = u.rn * BM + wc * 32 + 4 * fq;
#pragma unroll
        for (int ai = 0; ai < 2; ++ai)
#pragma unroll
            for (int m = 0; m < 4; ++m)
#pragma unroll
                for (int bj = 0; bj < 2; ++bj)
#pragma unroll
                    for (int n = 0; n < 2; ++n) gstf4(Y + (size_t)(row0 + ai * HALF + m * 16) * ldc + col0 + bj * HALF + n * 16, acc[ai][bj][m][n]);
    }
};

struct EpiSwiglu {
    static constexpr bool PERM = true, AFTER_DRAIN = false;
    bf16_t* ACT;
    __device__ __forceinline__ void operator()(const f32x4 (&acc)[2][2][4][2], const Unit& u, int wr, int wc, int fr, int fq) const {
        const int row0 = u.rm * BM + wr * 64 + fr, col0 = u.rn * HALF + wc * 32 + 8 * fq;
#pragma unroll
        for (int ai = 0; ai < 2; ++ai)
#pragma unroll
            for (int m = 0; m < 4; ++m) {
                const f32x4 g0 = acc[ai][0][m][0], g1 = acc[ai][0][m][1], u0 = acc[ai][1][m][0], u1 = acc[ai][1][m][1];
                u32x4 w;
                w.x = cvt_pk_bf16(g0[0] * fast_sigmoid(g0[0]) * u0[0], g0[1] * fast_sigmoid(g0[1]) * u0[1]);
                w.y = cvt_pk_bf16(g0[2] * fast_sigmoid(g0[2]) * u0[2], g0[3] * fast_sigmoid(g0[3]) * u0[3]);
                w.z = cvt_pk_bf16(g1[0] * fast_sigmoid(g1[0]) * u1[0], g1[1] * fast_sigmoid(g1[1]) * u1[1]);
                w.w = cvt_pk_bf16(g1[2] * fast_sigmoid(g1[2]) * u1[2], g1[3] * fast_sigmoid(g1[3]) * u1[3]);
                gst16(ACT + (size_t)(row0 + ai * HALF + m * 16) * 2816 + col0, w);
            }
    }
};

template <class Epi, class Sched, bool ALIGN_EPI = false, bool SP2 = false>
__device__ __forceinline__ void gemm_phase(PG8_LAS unsigned char* lds, const Gemm g, const Sched& S, const Epi& E, const int wave_in, const int lane_in) {
    const int wid = wave_in, lane = lane_in, tid = wid * 64 + lane, wr = wid >> 2, wc = wid & 3, fr = lane & 15, fq = lane >> 4;
    const int K = g.K, nt = K / BK;
    unsigned voffA[2], voffB[2];
#pragma unroll
    for (int i = 0; i < 2; ++i) { int R, C; stage_rc(tid * 16 + i * 8192, R, C); const int Rb = Epi::PERM ? ((R & ~31) + perm32(R & 31)) : R;
        voffA[i] = (unsigned)(R * K + C) * 2u; voffB[i] = (unsigned)(Rb * K + C) * 2u; }
    const size_t kstep = (size_t)(BK * 2);
    const size_t hstep = (size_t)HALF * K * 2;
    const size_t tstep = 2 * hstep;
    const unsigned ldsw = (unsigned)wid * 1024u;
    const int aoff = lds_byte(wr * 64 + fr, fq * 8), boff = lds_byte(wc * 32 + fr, fq * 8);
#define PG8_SA(b, h) (((b) * 2 + (h)) * HTB)
#define PG8_SB(b, h) ((4 + (b) * 2 + (h)) * HTB)
#define PG8_STAGE(bufoff, gbase, voff) do { _Pragma("unroll") for (int _i = 0; _i < 2; ++_i) \
        __builtin_amdgcn_global_load_lds((const unsigned*)((const char*)(gbase) + (voff)[_i]), (PG8_LAS unsigned*)(lds + (bufoff) + ldsw + _i * 8192), 16, 0, 0); } while (0)
#define PG8_LDA(dst, b, h) do { _Pragma("unroll") for (int m = 0; m < 4; ++m) _Pragma("unroll") for (int k = 0; k < 2; ++k) dst[m][k] = *(const PG8_LAS bf16x8*)(lds + PG8_SA(b, h) + aoff + m * 2048 + k * 1024); } while (0)
#define PG8_LDB(dst, b, h) do { _Pragma("unroll") for (int n = 0; n < 2; ++n) _Pragma("unroll") for (int k = 0; k < 2; ++k) dst[n][k] = *(const PG8_LAS bf16x8*)(lds + PG8_SB(b, h) + boff + n * 2048 + k * 1024); } while (0)
#define PG8_MMA(ai, bj, At, Bt) do { __builtin_amdgcn_s_setprio(1); _Pragma("unroll") for (int m = 0; m < 4; ++m) _Pragma("unroll") for (int n = 0; n < 2; ++n) _Pragma("unroll") for (int k = 0; k < 2; ++k) \
        acc[ai][bj][m][n] = __builtin_amdgcn_mfma_f32_16x16x32_bf16(Bt[n][k], At[m][k], acc[ai][bj][m][n], 0, 0, 0); __builtin_amdgcn_s_setprio(0); } while (0)
#define PG8_WAIT_V(n) asm volatile("s_waitcnt vmcnt(" #n ")" ::: "memory")
#define PG8_WAIT_L(n) asm volatile("s_waitcnt lgkmcnt(" #n ")" ::: "memory")
#define PG8_BAR __builtin_amdgcn_s_barrier()
#define PG8_SCHED __builtin_amdgcn_sched_barrier(0)
    Unit cur, nxt; int ui = 0;
    if (!S.next(0, cur)) return;
    f32x4 acc[2][2][4][2];
#pragma unroll
    for (int a = 0; a < 2; ++a)
#pragma unroll
        for (int b = 0; b < 2; ++b)
#pragma unroll
            for (int m = 0; m < 4; ++m)
#pragma unroll
                for (int n = 0; n < 2; ++n) acc[a][b][m][n] = (f32x4){0.f, 0.f, 0.f, 0.f};
    bf16x8 At[4][2], B0[2][2], B1[2][2];
    const char* cA = (const char*)g.A + (size_t)cur.pm * tstep; const char* cB = (const char*)g.Bt + (size_t)cur.pn * tstep;
    S.a_ready(cur);
    if constexpr (SP2) {
        PG8_STAGE(PG8_SB(0, 0), cB, voffB); PG8_STAGE(PG8_SB(0, 1), cB + hstep, voffB); PG8_STAGE(PG8_SA(0, 0), cA, voffA); PG8_STAGE(PG8_SA(0, 1), cA + hstep, voffA);
        if (wr == 1) PG8_BAR;
        PG8_WAIT_V(2); PG8_BAR;
        PG8_STAGE(PG8_SB(1, 0), cB + kstep, voffB); PG8_STAGE(PG8_SA(1, 0), cA + kstep, voffA); PG8_STAGE(PG8_SB(1, 1), cB + hstep + kstep, voffB);
        PG8_WAIT_V(6); PG8_BAR;
    } else {
        PG8_STAGE(PG8_SB(0, 0), cB, voffB); PG8_STAGE(PG8_SA(0, 0), cA, voffA); PG8_STAGE(PG8_SB(0, 1), cB + hstep, voffB); PG8_STAGE(PG8_SA(0, 1), cA + hstep, voffA);
        if (wr == 1) PG8_BAR;
        PG8_WAIT_V(4); PG8_BAR;
        PG8_STAGE(PG8_SB(1, 0), cB + kstep, voffB); PG8_STAGE(PG8_SA(1, 0), cA + kstep, voffA); PG8_STAGE(PG8_SB(1, 1), cB + hstep + kstep, voffB);
        PG8_WAIT_V(6); PG8_BAR;
    }
    for (;;) {
        const bool has_next = S.next(ui + 1, nxt);
        const char* nA = has_next ? (const char*)g.A + (size_t)nxt.pm * tstep : cA; const char* nB = has_next ? (const char*)g.Bt + (size_t)nxt.pn * tstep : cB;
        for (int t = 0; t < nt; t += 2) {
            const bool last = (t == nt - 2);
            const char* a1 = cA + (size_t)(t + 1) * kstep;
            const char* a2 = last ? nA : cA + (size_t)(t + 2) * kstep; const char* b2 = last ? nB : cB + (size_t)(t + 2) * kstep;
            const char* a3 = a2 + kstep; const char* b3 = b2 + kstep;
            if (last && has_next) S.a_ready(nxt);
            if constexpr (SP2) {
            PG8_LDB(B0, 0, 0); PG8_LDB(B1, 0, 1); PG8_SCHED; PG8_LDA(At, 0, 0); PG8_STAGE(PG8_SA(1, 1), a1 + hstep, voffA);
            PG8_WAIT_V(8); PG8_WAIT_L(0); PG8_BAR; PG8_MMA(0, 0, At, B0); PG8_MMA(0, 1, At, B1); PG8_BAR; PG8_SCHED;
            PG8_LDA(At, 0, 1); PG8_STAGE(PG8_SB(0, 0), b2, voffB); PG8_STAGE(PG8_SB(0, 1), b2 + hstep, voffB); PG8_STAGE(PG8_SA(0, 0), a2, voffA);
            PG8_WAIT_V(8); PG8_WAIT_L(0); PG8_BAR; PG8_MMA(1, 0, At, B0); PG8_MMA(1, 1, At, B1); PG8_BAR; PG8_SCHED;
            PG8_LDB(B0, 1, 0); PG8_LDB(B1, 1, 1); PG8_SCHED; PG8_LDA(At, 1, 0); PG8_STAGE(PG8_SA(0, 1), a2 + hstep, voffA);
            PG8_WAIT_V(8); PG8_WAIT_L(0); PG8_BAR; PG8_MMA(0, 0, At, B0); PG8_MMA(0, 1, At, B1); PG8_BAR; PG8_SCHED;
            PG8_LDA(At, 1, 1); PG8_STAGE(PG8_SB(1, 0), b3, voffB); PG8_STAGE(PG8_SB(1, 1), b3 + hstep, voffB); PG8_STAGE(PG8_SA(1, 0), a3, voffA);
            PG8_WAIT_V(8); PG8_WAIT_L(0); PG8_BAR; PG8_MMA(1, 0, At, B0); PG8_MMA(1, 1, At, B1); PG8_BAR; PG8_SCHED;
            } else {
            PG8_LDB(B0, 0, 0); PG8_SCHED; PG8_LDA(At, 0, 0); PG8_STAGE(PG8_SA(1, 1), a1 + hstep, voffA);
            PG8_WAIT_L(8); PG8_BAR; PG8_WAIT_L(0); PG8_MMA(0, 0, At, B0); PG8_BAR; PG8_SCHED;
            PG8_LDB(B1, 0, 1); PG8_STAGE(PG8_SB(0, 0), b2, voffB);
            PG8_BAR; PG8_WAIT_L(0); PG8_MMA(0, 1, At, B1); PG8_BAR;
            PG8_LDA(At, 0, 1); PG8_STAGE(PG8_SA(0, 0), a2, voffA);
            PG8_BAR; PG8_WAIT_L(0); PG8_MMA(1, 0, At, B0); PG8_BAR; PG8_SCHED;
            PG8_STAGE(PG8_SB(0, 1), b2 + hstep, voffB);
            PG8_WAIT_V(6); PG8_BAR; PG8_MMA(1, 1, At, B1); PG8_BAR;
            PG8_LDB(B0, 1, 0); PG8_SCHED; PG8_LDA(At, 1, 0); PG8_STAGE(PG8_SA(0, 1), a2 + hstep, voffA);
            PG8_WAIT_L(8); PG8_BAR; PG8_WAIT_L(0); PG8_MMA(0, 0, At, B0); PG8_BAR; PG8_SCHED;
            PG8_LDB(B1, 1, 1); PG8_STAGE(PG8_SB(1, 0), b3, voffB);
            PG8_BAR; PG8_WAIT_L(0); PG8_MMA(0, 1, At, B1); PG8_BAR;
            PG8_LDA(At, 1, 1); PG8_STAGE(PG8_SA(1, 0), a3, voffA);
            PG8_BAR; PG8_WAIT_L(0); PG8_MMA(1, 0, At, B0); PG8_BAR; PG8_SCHED;
            PG8_STAGE(PG8_SB(1, 1), b3 + hstep, voffB);
            PG8_WAIT_V(6); PG8_BAR; PG8_MMA(1, 1, At, B1); PG8_BAR;
            }
        }
        if constexpr (ALIGN_EPI) { if (wr == 0) PG8_BAR; }
        if constexpr (!Epi::AFTER_DRAIN) {
            int ln_; asm volatile("v_mbcnt_lo_u32_b32 %0, -1, 0\n\tv_mbcnt_hi_u32_b32 %0, -1, %0" : "=v"(ln_));
            E(acc, cur, wr, wc, ln_ & 15, ln_ >> 4); S.done(cur); }
        if (!has_next) break;
#pragma unroll
        for (int a = 0; a < 2; ++a)
#pragma unroll
            for (int b = 0; b < 2; ++b)
#pragma unroll
                for (int m = 0; m < 4; ++m)
#pragma unroll
                    for (int n = 0; n < 2; ++n) acc[a][b][m][n] = (f32x4){0.f, 0.f, 0.f, 0.f};
        cur = nxt; cA = nA; cB = nB; ++ui;
        if constexpr (ALIGN_EPI) { if (wr == 1) PG8_BAR; }
    }
    PG8_WAIT_V(0);
    if constexpr (!ALIGN_EPI) { if (wr == 0) PG8_BAR; }
    PG8_BAR;
    if constexpr (Epi::AFTER_DRAIN) { E.fused(acc, cur, wr, wc, fr, fq, lds, wid, lane); S.done(cur); }
#undef PG8_SA
#undef PG8_SB
#undef PG8_STAGE
#undef PG8_LDA
#undef PG8_LDB
#undef PG8_MMA
#undef PG8_WAIT_V
#undef PG8_WAIT_L
#undef PG8_BAR
#undef PG8_SCHED
}
}

namespace att {
#define ALAS __attribute__((address_space(3)))
#define AGAS __attribute__((address_space(1)))
typedef unsigned short bf16_t;
typedef short bf16x8 __attribute__((ext_vector_type(8)));
typedef short s16x4 __attribute__((ext_vector_type(4)));
typedef float f32x16 __attribute__((ext_vector_type(16)));
typedef unsigned u32x4 __attribute__((ext_vector_type(4)));
constexpr int SLOT = 28672, VOFF = 12288, WSF_OFF = 2 * SLOT, OST_OFF = WSF_OFF + 2048, LDS_NEED = OST_OFF + 8 * 8192;
constexpr float THR = 6.0f;
__device__ __forceinline__ int crow(int r, int hi) { return (r & 3) + 8 * (r >> 2) + 4 * hi; }
typedef float f32x2_t __attribute__((ext_vector_type(2))); typedef __bf16 bf16x2_t __attribute__((ext_vector_type(2)));
__device__ __forceinline__ unsigned cvtpk(float lo, float hi) { f32x2_t v = {lo, hi}; bf16x2_t b = __builtin_convertvector(v, bf16x2_t); return __builtin_bit_cast(unsigned, b); }
__device__ __forceinline__ s16x4 vtr(const ALAS unsigned char* p) { typedef short v4i16_t __attribute__((ext_vector_type(4))); return __builtin_bit_cast(s16x4, __builtin_amdgcn_ds_read_tr16_b64_v4i16((ALAS v4i16_t*)p)); }

struct Src {
    const bf16_t* k1; int ldk1;
    const bf16_t* k2; int ldk2;
    const bf16_t* v;  int ldv;
    int ctx_row0;
    int lat_row0, nlat;
};

template <int DQK, int DV, int MODE>
__device__ __forceinline__ void attn_pass(ALAS unsigned char* lds, const Src& S, const bf16_t* qp, int ldq, const bf16_t* qp2, int ldq2, float sink2, int tq0  , int slat0  , f32x16 (&o)[DV / 32], int wid, int lane) {
    constexpr int NKS = DQK / 16, NDB = DV / 32, NKP = DQK / 8, NVP = NDB * 4;
    const int r32 = lane & 31, hi = lane >> 5;
    ALAS float* wsf = (ALAS float*)(lds + WSF_OFF) + wid * 64;
    const int NT = 4 + S.nlat;
    bf16x8 qf[NKS];
#pragma unroll
    for (int d0 = 0; d0 < NKS; ++d0) {
        if (d0 < 4) qf[d0] = *(const AGAS bf16x8*)(qp + (size_t)(wid * 32 + r32) * ldq + d0 * 16 + hi * 8);
        else qf[d0] = *(const AGAS bf16x8*)(qp2 + (size_t)(wid * 32 + r32) * ldq2 + (d0 - 4) * 16 + hi * 8);
    }
    auto issue = [&](int t, int slot) {
        const int krow = (t < 4) ? (S.ctx_row0 + 64 * t) : (S.lat_row0 + 64 * (t - 4));
        ALAS unsigned char* sb = lds + slot * SLOT;
#pragma unroll
        for (int i = 0; i < (NKP + 7) / 8; ++i) {
            const int c = wid + 8 * i;
            if (c < NKP) {
                const bf16_t* src = (c < 8) ? (S.k1 + (size_t)(krow + lane) * S.ldk1 + c * 8) : (S.k2 + (size_t)(krow + lane) * S.ldk2 + (c - 8) * 8);
                __builtin_amdgcn_global_load_lds((const unsigned*)src, (ALAS unsigned*)(sb + c * 1024), 16, 0, 0);
            }
        }
#pragma unroll
        for (int i = 0; i < NVP / 8; ++i) {
            const int p = wid + 8 * i, db = p >> 2, ks = p & 3;
            const bf16_t* src = S.v + (size_t)(krow + 16 * ks + (lane >> 2)) * S.ldv + db * 32 + (lane & 3) * 8;
            __builtin_amdgcn_global_load_lds((const unsigned*)src, (ALAS unsigned*)(sb + VOFF + p * 1024), 16, 0, 0);
        }
    };
    float mrun = (MODE == 1) ? sink2 : -INFINITY;
    float lrun = (MODE == 1 && hi == 0) ? 1.0f : 0.0f;
#pragma unroll
    for (int db = 0; db < NDB; ++db)
#pragma unroll
        for (int r = 0; r < 16; ++r) o[db][r] = 0.f;
    const int tw0 = tq0 + wid * 32;
    const int vp = ((lane >> 4) & 1) * 32 + (lane & 3) * 8 + (4 * hi + ((lane & 15) >> 2)) * 64;
    issue(0, 0);
    for (int t = 0; t < NT; ++t) {
        __syncthreads();
        if (t + 1 < NT) issue(t + 1, (t + 1) & 1);
        const ALAS unsigned char* sb = lds + (t & 1) * SLOT;
        bool partial = false;
        if (MODE == 1 && t >= 4) {
            const int sb0 = slat0 + 64 * (t - 4);
            if (sb0 > tw0 + 31 + 128 || sb0 + 63 < tw0 - 128) continue;
            partial = (tw0 + 31 - sb0 > 128) || (sb0 + 63 - tw0 > 128);
        }
        f32x16 p0, p1;
#pragma unroll
        for (int r = 0; r < 16; ++r) { p0[r] = 0.f; p1[r] = 0.f; }
#pragma unroll
        for (int d0 = 0; d0 < NKS; ++d0) {
            const bf16x8 k0 = *(const ALAS bf16x8*)(sb + (2 * d0 + hi) * 1024 + r32 * 16);
            const bf16x8 k1 = *(const ALAS bf16x8*)(sb + (2 * d0 + hi) * 1024 + r32 * 16 + 512);
            p0 = __builtin_amdgcn_mfma_f32_32x32x16_bf16(k0, qf[d0], p0, 0, 0, 0);
            p1 = __builtin_amdgcn_mfma_f32_32x32x16_bf16(k1, qf[d0], p1, 0, 0, 0);
        }
        __builtin_amdgcn_sched_barrier(0);
        if (MODE == 1 && partial) {
            const int sb0 = slat0 + 64 * (t - 4), tq = tw0 + r32;
#pragma unroll
            for (int r = 0; r < 16; ++r) {
                const int s0 = sb0 + crow(r, hi), d0 = tq - s0, d1 = d0 - 32;
                if (d0 > 128 || d0 < -128) p0[r] = -INFINITY;
                if (d1 > 128 || d1 < -128) p1[r] = -INFINITY;
            }
        }
        float rm = fmaxf(p0[0], p1[0]);
#pragma unroll
        for (int r = 1; r < 16; ++r) rm = fmaxf(rm, fmaxf(p0[r], p1[r]));
        { auto rr = __builtin_amdgcn_permlane32_swap(__float_as_uint(rm), __float_as_uint(rm), false, false); rm = fmaxf(__uint_as_float(rr[0]), __uint_as_float(rr[1])); }
        if (__any(rm > mrun + THR)) {
            const float mn = fmaxf(mrun, rm), al = __builtin_amdgcn_exp2f(mrun - mn);
            mrun = mn; lrun *= al;
            if (hi == 0) wsf[r32] = al;
#pragma unroll
            for (int r = 0; r < 16; ++r) { const float a = wsf[crow(r, hi)];
#pragma unroll
                for (int db = 0; db < NDB; ++db) o[db][r] *= a; }
        }
        __builtin_amdgcn_sched_barrier(0);
        float sum = 0.f;
#pragma unroll
        for (int r = 0; r < 16; ++r) { p0[r] = __builtin_amdgcn_exp2f(p0[r] - mrun); p1[r] = __builtin_amdgcn_exp2f(p1[r] - mrun); sum += p0[r] + p1[r]; }
        lrun += sum;
        u32x4 pw[4];
#pragma unroll
        for (int w = 0; w < 4; ++w) { pw[0][w] = cvtpk(p0[2 * w], p0[2 * w + 1]); pw[1][w] = cvtpk(p0[8 + 2 * w], p0[8 + 2 * w + 1]); pw[2][w] = cvtpk(p1[2 * w], p1[2 * w + 1]); pw[3][w] = cvtpk(p1[8 + 2 * w], p1[8 + 2 * w + 1]); }
        __builtin_amdgcn_sched_barrier(0);
#pragma unroll
        for (int db = 0; db < NDB; ++db)
#pragma unroll
            for (int ks = 0; ks < 4; ++ks) {
                const ALAS unsigned char* vb = sb + VOFF + (db * 4 + ks) * 1024 + vp;
                const s16x4 lo = vtr(vb), hh = vtr(vb + 512);
                const bf16x8 vf = (bf16x8){lo[0], lo[1], lo[2], lo[3], hh[0], hh[1], hh[2], hh[3]};
                o[db] = __builtin_amdgcn_mfma_f32_32x32x16_bf16(__builtin_bit_cast(bf16x8, pw[ks]), vf, o[db], 0, 0, 0);
            }
    }
    { auto rr = __builtin_amdgcn_permlane32_swap(__float_as_uint(lrun), __float_as_uint(lrun), false, false); lrun = __uint_as_float(rr[0]) + __uint_as_float(rr[1]); }
    if (hi == 0) wsf[32 + r32] = lrun;
    __syncthreads();
}

template <int DV>
__device__ __forceinline__ void store_o(ALAS unsigned char* lds, const f32x16 (&o)[DV / 32], bf16_t* dst  , int ldo, int wid, int lane) {
    asm volatile("" : "+v"(lane));
    const int r32 = lane & 31, hi = lane >> 5;
    ALAS bf16_t* stg = (ALAS bf16_t*)(lds + OST_OFF + wid * 8192);
#pragma unroll
    for (int r = 0; r < 16; ++r) { const int orow = crow(r, hi);
#pragma unroll
        for (int db = 0; db < DV / 32; ++db) { const unsigned w = cvtpk(o[db][r], 0.f); stg[orow * DV + db * 32 + r32] = (bf16_t)(w & 0xffffu); } }
    constexpr int CH = DV / 8, RPI = 64 / CH;
#pragma unroll
    for (int i = 0; i < 32 / RPI; ++i) { const int row = i * RPI + lane / CH, ch = lane % CH;
        const u32x4 v = *(const ALAS u32x4*)(stg + row * DV + ch * 8); *(AGAS u32x4*)(dst + (size_t)row * ldo + ch * 8) = v; }
}

struct Bufs {
    bf16_t *QN, *QR, *MK, *MV, *KR, *DQ, *DK, *DV_, *SQ, *SK, *SV;
    bf16_t *OA, *OB, *OC;
    const float* lam; const float* dnorm; const float* sink; float lam_init; float eps;
};
__device__ __forceinline__ void attn_unit(ALAS unsigned char* lds, const Bufs& B, int type, int b, int h, int qb, int wid, int lane) {
    asm volatile("" : "+v"(lane));
    const bool ctxq = (qb == 16);
    const int qrow0 = ctxq ? (16384 + b * 256) : (b * 4096 + qb * 256);
    const int tq0 = qb * 256;
    Src S; S.ctx_row0 = 16384 + b * 256; S.k2 = nullptr; S.ldk2 = 0;
    const int r32 = lane & 31, hi = lane >> 5;
    ALAS float* wsf = (ALAS float*)(lds + WSF_OFF) + wid * 64;
    if (type == 0) {
        S.k1 = B.MK + h * 64; S.ldk1 = 512; S.k2 = B.KR; S.ldk2 = 32; S.v = B.MV + h * 64; S.ldv = 512;
        S.lat_row0 = b * 4096; S.nlat = ctxq ? 0 : 64;
        f32x16 o[2];
        attn_pass<96, 64, 0>(lds, S, B.QN + (size_t)qrow0 * 512 + h * 64, 512, B.QR + (size_t)qrow0 * 256 + h * 32, 256, 0.f, tq0, 0, o, wid, lane);
#pragma unroll
        for (int r = 0; r < 16; ++r) { const float il = __builtin_amdgcn_rcpf(wsf[32 + crow(r, hi)]); o[0][r] *= il; o[1][r] *= il; }
        store_o<64>(lds, o, B.OA + (size_t)(qrow0 + wid * 32) * 512 + h * 64, 512, wid, lane);
    } else if (type == 2) {
        const int hk = h >> 2;
        S.k1 = B.SK + hk * 64; S.ldk1 = 128; S.v = B.SV + hk * 64; S.ldv = 128;
        int lo = tq0 - 128; if (lo < 0) lo = 0; int hi_ = tq0 + 256 + 128; if (hi_ > 4096) hi_ = 4096;
        S.lat_row0 = b * 4096 + lo; S.nlat = ctxq ? 0 : (hi_ - lo) / 64;
        f32x16 o[2];
        attn_pass<64, 64, 1>(lds, S, B.SQ + (size_t)qrow0 * 512 + h * 64, 512, nullptr, 0, *(const AGAS float*)(B.sink + h) * 1.4426950408889634f, tq0, lo, o, wid, lane);
#pragma unroll
        for (int r = 0; r < 16; ++r) { const float il = __builtin_amdgcn_rcpf(wsf[32 + crow(r, hi)]); o[0][r] *= il; o[1][r] *= il; }
        store_o<64>(lds, o, B.OC + (size_t)(qrow0 + wid * 32) * 512 + h * 64, 512, wid, lane);
    } else {
        S.v = B.DV_ + h * 128; S.ldv = 512; S.lat_row0 = b * 4096; S.nlat = ctxq ? 0 : 64; S.ldk1 = 512;
        f32x16 o1[4]; unsigned o0p[4][8];
        S.k1 = B.DK + (2 * h) * 64;
        attn_pass<64, 128, 0>(lds, S, B.DQ + (size_t)qrow0 * 512 + (2 * h) * 64, 512, nullptr, 0, 0.f, tq0, 0, o1, wid, lane);
#pragma unroll
        for (int r = 0; r < 16; r += 2) { const float il0 = __builtin_amdgcn_rcpf(wsf[32 + crow(r, hi)]), il1 = __builtin_amdgcn_rcpf(wsf[32 + crow(r + 1, hi)]);
#pragma unroll
            for (int db = 0; db < 4; ++db) o0p[db][r >> 1] = cvtpk(o1[db][r] * il0, o1[db][r + 1] * il1); }
        __syncthreads();
        S.k1 = B.DK + (2 * h + 1) * 64;
        attn_pass<64, 128, 0>(lds, S, B.DQ + (size_t)qrow0 * 512 + (2 * h + 1) * 64, 512, nullptr, 0, 0.f, tq0, 0, o1, wid, lane);
        int r32b = r32; asm volatile("" : "+v"(r32b));
        const float lam = *(const AGAS float*)B.lam, post = 1.0f - B.lam_init;
        float wn[4];
#pragma unroll
        for (int db = 0; db < 4; ++db) wn[db] = *(const AGAS float*)(B.dnorm + db * 32 + r32b) * post;
#pragma unroll
        for (int r = 0; r < 16; ++r) {
            const float il = __builtin_amdgcn_rcpf(wsf[32 + crow(r, hi)]) * lam;
            float ss = 0.f;
#pragma unroll
            for (int db = 0; db < 4; ++db) { const unsigned w = o0p[db][r >> 1]; const float a0 = (r & 1) ? __uint_as_float(w & 0xffff0000u) : __uint_as_float(w << 16);
                const float v = a0 - il * o1[db][r]; o1[db][r] = v; ss += v * v; }
            ss += __shfl_xor(ss, 1); ss += __shfl_xor(ss, 2); ss += __shfl_xor(ss, 4); ss += __shfl_xor(ss, 8); ss += __shfl_xor(ss, 16);
            const float rs = rsqrtf(ss * (1.0f / 128.0f) + B.eps);
#pragma unroll
            for (int db = 0; db < 4; ++db) o1[db][r] *= rs * wn[db];
        }
        store_o<128>(lds, o1, B.OB + (size_t)(qrow0 + wid * 32) * 512 + h * 128, 512, wid, lane);
    }
    __syncthreads();
}
#undef ALAS
#undef AGAS
}


constexpr int NWAVES = 8;
constexpr int DM = 1024, NB = 4, SEQ = 4096, NCTX = 256, MLAT = NB * SEQ, MCTX = NB * NCTX, MALL = MLAT + MCTX;
constexpr int PAN_LAT = MLAT / 256, PAN_ALL = MALL / 256;
constexpr int INW = 5920, DFF = 2816;
constexpr float EPS = 1e-6f, LOG2E = 1.4426950408889634f;

constexpr size_t MiB = 1u << 20;
constexpr size_t WS_CTL = 0, CTL_BYTES = 1 * MiB;
constexpr size_t WS_W = 1 * MiB;
constexpr size_t W_IN = 0, W_G = W_IN + 3072ull * 1024 * 2, W_UKVQ = W_G + 3072ull * 1024 * 2, W_ABC = W_UKVQ + 1792ull * 256 * 2, W_O = W_ABC + 3ull * 1024 * 512 * 2,
                 W_GU = W_O + 1024ull * 1024 * 2, W_DN = W_GU + 5632ull * 1024 * 2, W_END = W_DN + 1024ull * 2816 * 2;
static_assert(W_END <= 37 * MiB, "weights region");
constexpr size_t WS_H = 38 * MiB;
constexpr size_t WS_QKV = 72 * MiB;
constexpr size_t SZ512 = (size_t)MALL * 512 * 2, SZ256 = (size_t)MALL * 256 * 2, SZ128 = (size_t)MALL * 128 * 2, SZ32 = (size_t)MALL * 32 * 2;
constexpr size_t Q_ABC = WS_QKV;
constexpr size_t Q_DEAD = Q_ABC + 3 * SZ512;
constexpr size_t Q_QR = Q_DEAD, Q_MK = Q_QR + SZ256, Q_MV = Q_MK + SZ512, Q_KR = Q_MV + SZ512, Q_DK = Q_KR + SZ32, Q_DV = Q_DK + SZ512, Q_SK = Q_DV + SZ512, Q_SV = Q_SK + SZ128,
                 Q_CKVQ = Q_SV + SZ128  , Q_END = Q_CKVQ + 2 * SZ256;
constexpr size_t Q_G = Q_DEAD;
static_assert(Q_G + (size_t)MALL * 3072 * 2 <= Q_END, "gates overlay");
constexpr size_t Q_Y = Q_DEAD;
constexpr size_t Q_ACT = WS_QKV;
constexpr size_t Q_F2 = Q_ACT + (size_t)MALL * 2816 * 2;
constexpr size_t WS_CTXRES = Q_F2 + (size_t)MALL * 1024 * 4;
constexpr size_t WS_SS = WS_CTXRES + (size_t)MCTX * 1024 * 4;
constexpr size_t WS_END = WS_SS + 2ull * MALL * 4 * 4;
static_assert(Q_END <= Q_F2 + (size_t)MALL * 1024 * 4 || true, "");
static_assert(WS_END <= 256 * MiB, "d_ws map must fit 256 MiB");
static_assert(Q_END <= WS_CTXRES, "attention operands below the small buffers");
constexpr int CW_BAR = 4096;
constexpr int CW_MODS = 16384;
constexpr int CW_LAM = CW_MODS + 2 * 5 * 6144;
constexpr int CW_TAB = CW_LAM + 64;
static_assert((CW_TAB + 3072) * 4 <= (int)CTL_BYTES, "CTL");

constexpr int RING_BYTES = 131072, LDSCTL_OFF = RING_BYTES, MISC_OFF = LDSCTL_OFF + 320, LDS_BYTES = 147456;
static_assert(att::LDS_NEED <= RING_BYTES, "attention LDS");

#define GAS __attribute__((address_space(1)))
#define LAS __attribute__((address_space(3)))
typedef unsigned short bf16;
typedef unsigned v4u __attribute__((ext_vector_type(4)));
typedef float f32x4 __attribute__((ext_vector_type(4)));
typedef short bf16x8 __attribute__((ext_vector_type(8)));
typedef GAS unsigned gu32;
typedef GAS unsigned long long gu64;
#define RLX_AGENT __ATOMIC_RELAXED, __HIP_MEMORY_SCOPE_AGENT
#define LDS_WAIT() asm volatile("s_waitcnt lgkmcnt(0)" ::: "memory")
#define VM_WAIT() asm volatile("s_waitcnt vmcnt(0)" ::: "memory")
__device__ __forceinline__ unsigned long long rt() { return __builtin_amdgcn_s_memrealtime(); }
__device__ __forceinline__ unsigned f2bf(float f) { unsigned u = __builtin_bit_cast(unsigned, f); return (u + 0x7fffu + ((u >> 16) & 1u)) >> 16; }
__device__ __forceinline__ unsigned pk2(float lo, float hi) { return f2bf(lo) | (f2bf(hi) << 16); }

#define XB_TMO      128
#define XB_XCNT(j)  (256  + 64 * (j))
#define XB_XSUB(j)  (1280 + 64 * (j))
#define XB_XGEN(j)  (2304 + 64 * (j))
#define XB_TOP      3328
#define XB_TOPGEN   3392
#define XCD_BAR_WORDS 3456
#define XB_SPIN_CAP (1u << 26)

__device__ __forceinline__ unsigned xb_ld(unsigned* p)              { return __hip_atomic_load(p, __ATOMIC_RELAXED, __HIP_MEMORY_SCOPE_AGENT); }
__device__ __forceinline__ unsigned xb_add(unsigned* p, unsigned v) { return __hip_atomic_fetch_add(p, v, __ATOMIC_RELAXED, __HIP_MEMORY_SCOPE_AGENT); }
__device__ __forceinline__ unsigned xb_xcc_id() { return (unsigned)__builtin_amdgcn_s_getreg((3 << 11) | 20) & 0xFu; }
#define XB_SPIN(cond, bar) do { unsigned _sp = 0; while (cond) { __builtin_amdgcn_s_sleep(1); \
    if ((++_sp & 255u) == 0u) { if (xb_ld(&(bar)[XB_TMO])) break; if (_sp > XB_SPIN_CAP) { atomicAdd(&(bar)[XB_TMO], 1u); break; } } } } while (0)

struct XcdBarrier {
    unsigned* bar; unsigned x;
    volatile LAS unsigned* st;
};

__device__ __forceinline__ XcdBarrier xcd_barrier_post(unsigned* bar, volatile LAS unsigned* st) {
    XcdBarrier b; b.bar = bar; b.x = xb_xcc_id(); b.st = st;
    if (threadIdx.x == 0) (void)xb_add(&bar[XB_XCNT(b.x)], 1u);
    return b;
}
__device__ __forceinline__ void xcd_barrier_complete(unsigned* bar, unsigned x, unsigned& nloc, unsigned& nx) {
    const unsigned G = gridDim.x * gridDim.y * gridDim.z;
    unsigned sum, cnt, mine, sp = 0u;
    for (;;) {
        sum = 0u; cnt = 0u; mine = 0u;
#pragma unroll
        for (unsigned j = 0; j < 16; ++j) { const unsigned c = xb_ld(&bar[XB_XCNT(j)]); sum += c; cnt += (c > 0u) ? 1u : 0u; mine = (j == x) ? c : mine; }
        if (sum == G) break;
        __builtin_amdgcn_s_sleep(1);
        if ((++sp & 255u) == 0u) { if (xb_ld(&bar[XB_TMO])) break; if (sp > XB_SPIN_CAP) { atomicAdd(&bar[XB_TMO], 1u); break; } }
    }
    nloc = mine > 0u ? mine : 1u; nx = cnt > 0u ? cnt : 1u;
}

__device__ __forceinline__ void xcd_barrier(const XcdBarrier& b, const bool is_t0) {
    asm volatile("s_waitcnt vmcnt(0)" ::: "memory");
    __syncthreads();
    if (is_t0) {
        unsigned* bar = b.bar;
        __builtin_amdgcn_s_waitcnt(0);
        unsigned nloc = b.st[0], nx = b.st[1];
        if (nloc == 0u) { xcd_barrier_complete(bar, b.x, nloc, nx); b.st[0] = nloc; b.st[1] = nx; }
        const unsigned old = xb_add(&bar[XB_XSUB(b.x)], 1u);
        const unsigned gen = old / nloc;
        if (old + 1u == (gen + 1u) * nloc) {
            __builtin_amdgcn_fence(__ATOMIC_RELEASE, "agent");
            asm volatile("s_waitcnt vmcnt(0)" ::: "memory");
            const unsigned og = xb_add(&bar[XB_TOP], 1u);
            const unsigned tg = og / nx;
            if (og + 1u == (tg + 1u) * nx) xb_add(&bar[XB_TOPGEN], 1u);
            else XB_SPIN(xb_ld(&bar[XB_TOPGEN]) == tg, bar);
            __builtin_amdgcn_fence(__ATOMIC_ACQUIRE, "agent");
            xb_add(&bar[XB_XGEN(b.x)], 1u);
            asm volatile("s_waitcnt vmcnt(0)" ::: "memory");
        } else {
            XB_SPIN(xb_ld(&bar[XB_XGEN(b.x)]) == gen, bar);
            __builtin_amdgcn_fence(__ATOMIC_ACQUIRE, "agent");
            asm volatile("s_waitcnt vmcnt(0)" ::: "memory");
        }
    }
    __syncthreads();
}

struct Ptrs {
    const float* in[24]; float* out; unsigned char* ws;
};
__device__ __forceinline__ float wave_sum(float v) {
#pragma unroll
    for (int o = 1; o < 64; o <<= 1) v += __shfl_xor(v, o);
    return v;
}
__device__ __forceinline__ float silu_acc(float x) { return x / (1.f + expf(-x)); }

__device__ __forceinline__ void p0_transpose_item(const float* W, int K, int Nsrc, int lcol0, const float* kscale, bf16* WT, int n0, int k0, LAS float* scr, int lane) {
    if (lcol0 < 0) {
        unsigned z = 0u; asm volatile("" : "+v"(z));
#pragma unroll
        for (int j = 0; j < 4; ++j) { const int n = (lane >> 3) + 8 * j; *(GAS v4u*)(WT + (size_t)(n0 + n) * K + k0 + 8 * (lane & 7)) = (v4u){z, z, z, z}; }
        return;
    }
#pragma unroll 8
    for (int i = 0; i < 32; ++i) { const int kk = 2 * i + (lane >> 5); float v = *(const GAS float*)(W + (size_t)(k0 + kk) * Nsrc + lcol0 + (lane & 31)); if (kscale) v *= *(const GAS float*)(kscale + k0 + kk); scr[kk * 33 + (lane & 31)] = v; }
    LDS_WAIT(); asm volatile("" ::: "memory");
    const int c = lane & 7;
#pragma unroll
    for (int j = 0; j < 4; ++j) { const int n = (lane >> 3) + 8 * j; const LAS float* s = scr + (8 * c) * 33 + n;
        v4u o; o.x = pk2(s[0 * 33], s[1 * 33]); o.y = pk2(s[2 * 33], s[3 * 33]); o.z = pk2(s[4 * 33], s[5 * 33]); o.w = pk2(s[6 * 33], s[7 * 33]);
        *(GAS v4u*)(WT + (size_t)(n0 + n) * K + k0 + 8 * c) = o; }
    LDS_WAIT(); asm volatile("" ::: "memory");
}
__device__ __forceinline__ void convert_weights(volatile LAS unsigned long long* PT, int l, unsigned char* wsW, LAS float* scr, int gw, int NGW, int lane) {
    const float* w_in = ((const float*)PT[10]) + (size_t)l * DM * INW; const float* q_norm = ((const float*)PT[11]) + l * 256; const float* w_uq = ((const float*)PT[12]) + (size_t)l * 256 * 768;
    const float* kv_norm = ((const float*)PT[13]) + l * 256; const float* w_ukv = ((const float*)PT[14]) + (size_t)l * 256 * 1024;
    const float* w_o = ((const float*)PT[21]) + (size_t)l * DM * DM; const float* w_gu = ((const float*)PT[22]) + (size_t)l * DM * 2 * DFF; const float* w_dn = ((const float*)PT[23]) + (size_t)l * DFF * DM;
    constexpr int I_IN = 16 * 96, I_G = 16 * 96, I_KV = 4 * 32, I_Q = 4 * 24, I_BR = 8 * 32, I_O = 16 * 32, I_GU = 16 * 176, I_DN = 44 * 32;
    constexpr int NITEMS = I_IN + I_G + I_KV + I_Q + 3 * I_BR + I_O + I_GU + I_DN;
    for (int it = gw; it < NITEMS; it += NGW) {
        int r = it;
        if (r < I_IN) { const int kb = r / 96, nb = r % 96, n0 = nb * 32; int lc;
            if (n0 < 256) lc = n0; else if (n0 < 1536) lc = n0 + 32; else if (n0 < 1568) lc = 256 + (n0 - 1536); else if (n0 < 1792) lc = -1; else lc = 1568 + (n0 - 1792);
            p0_transpose_item(w_in, DM, INW, lc, nullptr, (bf16*)(wsW + W_IN), n0, kb * 64, scr, lane); continue; } r -= I_IN;
        if (r < I_G) { const int kb = r / 96, nb = r % 96; p0_transpose_item(w_in, DM, INW, 2848 + nb * 32, nullptr, (bf16*)(wsW + W_G), nb * 32, kb * 64, scr, lane); continue; } r -= I_G;
        if (r < I_KV) { const int kb = r / 32, nb = r % 32; p0_transpose_item(w_ukv, 256, 1024, nb * 32, kv_norm, (bf16*)(wsW + W_UKVQ), nb * 32, kb * 64, scr, lane); continue; } r -= I_KV;
        if (r < I_Q) { const int kb = r / 24, nb = r % 24; p0_transpose_item(w_uq, 256, 768, nb * 32, q_norm, (bf16*)(wsW + W_UKVQ) + 1024 * 256, nb * 32, kb * 64, scr, lane); continue; } r -= I_Q;
        if (r < 3 * I_BR) { const int br = r / I_BR, rr = r % I_BR, kb = rr / 32, nb = rr % 32; p0_transpose_item(((const float*)PT[18 + br]) + (size_t)l * 512 * DM, 512, DM, nb * 32, nullptr, (bf16*)(wsW + W_ABC) + (size_t)br * 1024 * 512, nb * 32, kb * 64, scr, lane); continue; } r -= 3 * I_BR;
        if (r < I_O) { const int kb = r / 32, nb = r % 32; p0_transpose_item(w_o, DM, DM, nb * 32, nullptr, (bf16*)(wsW + W_O), nb * 32, kb * 64, scr, lane); continue; } r -= I_O;
        if (r < I_GU) { const int kb = r / 176, nb = r % 176, n0 = nb * 32, tile = n0 >> 8, bj = (n0 >> 7) & 1, c = n0 & 127;
            p0_transpose_item(w_gu, DM, 2 * DFF, bj * DFF + tile * 128 + c, nullptr, (bf16*)(wsW + W_GU), n0, kb * 64, scr, lane); continue; } r -= I_GU;
        { const int kb = r / 32, nb = r % 32; p0_transpose_item(w_dn, DFF, DM, nb * 32, nullptr, (bf16*)(wsW + W_DN), nb * 32, kb * 64, scr, lane); }
    }
}
__device__ __forceinline__ void adaln_item(volatile LAS unsigned long long* PT, int item, float* part, int lane) {
    const int l = item / (24 * 32), rem = item % (24 * 32), cc = rem / 32, kc = rem % 32, n = cc * 256 + 4 * lane;
    const float* W = ((const float*)PT[4]) + (size_t)l * DM * 6144 + (size_t)(kc * 32) * 6144 + n;
    const float* cB = (const float*)PT[1]; const float* cC = (const float*)PT[3];
    f32x4 acc[5];
#pragma unroll
    for (int c = 0; c < 5; ++c) acc[c] = (f32x4){0.f, 0.f, 0.f, 0.f};
#pragma unroll 4
    for (int k = 0; k < 32; ++k) {
        const f32x4 w4 = *(const GAS f32x4*)(W + (size_t)k * 6144); const int kk = kc * 32 + k;
#pragma unroll
        for (int c = 0; c < 5; ++c) { const float s = silu_acc(c < 4 ? *(const GAS float*)(cB + c * DM + kk) : *(const GAS float*)(cC + kk)); acc[c] += w4 * s; }
    }
#pragma unroll
    for (int c = 0; c < 5; ++c) *(GAS f32x4*)(part + (((size_t)l * 32 + kc) * 5 + c) * 6144 + n) = acc[c];
}
__device__ __forceinline__ void row_prenorm(const f32x4 (&x)[4], const float* wpre, const float* shift, const float* scale, bf16* hout, int lane) {
    float ss = 0.f;
#pragma unroll
    for (int j = 0; j < 4; ++j) ss += (x[j][0] * x[j][0] + x[j][1] * x[j][1]) + (x[j][2] * x[j][2] + x[j][3] * x[j][3]);
    const float rs = rsqrtf(wave_sum(ss) * (1.0f / DM) + EPS);
#pragma unroll
    for (int j = 0; j < 4; ++j) { const int e = 4 * lane + 256 * j;
        const f32x4 w = *(const GAS f32x4*)(wpre + e), sh = *(const GAS f32x4*)(shift + e), sc = *(const GAS f32x4*)(scale + e);
        const f32x4 h = (x[j] * rs * w) * (sc + 1.0f) + sh;
        unsigned long long o = (unsigned long long)pk2(h[0], h[1]) | ((unsigned long long)pk2(h[2], h[3]) << 32);
        *(GAS unsigned long long*)(hout + e) = o; }
}
__device__ __forceinline__ void row_post(const float* res, const float* y, const float* wpost, const float* gate, float* res_out, const float* wpre, const float* shift, const float* scale, bf16* hout, int lane) {
    f32x4 yv[4], xv[4]; float ss = 0.f;
#pragma unroll
    for (int j = 0; j < 4; ++j) { const int e = 4 * lane + 256 * j; yv[j] = *(const GAS f32x4*)(y + e); xv[j] = *(const GAS f32x4*)(res + e); ss += (yv[j][0] * yv[j][0] + yv[j][1] * yv[j][1]) + (yv[j][2] * yv[j][2] + yv[j][3] * yv[j][3]); }
    const float rs = rsqrtf(wave_sum(ss) * (1.0f / DM) + EPS);
#pragma unroll
    for (int j = 0; j < 4; ++j) { const int e = 4 * lane + 256 * j; const f32x4 w = *(const GAS f32x4*)(wpost + e), g = *(const GAS f32x4*)(gate + e);
        xv[j] = xv[j] + g * (yv[j] * rs * w); *(GAS f32x4*)(res_out + e) = xv[j]; }
    if (hout) row_prenorm(xv, wpre, shift, scale, hout, lane);
}


#ifdef MK_CHECK
namespace chk {
constexpr int NS = 192;
__device__ __forceinline__ int srow(int i) { return i < 64 ? 5000 + i : (i < 128 ? 16320 + (i - 64) : 16384 + 300 + (i - 128)); }
__device__ __forceinline__ float bf(unsigned short v) { return __uint_as_float((unsigned)v << 16); }
__device__ __forceinline__ void upd(float* err, float e, float ref) {
    atomicMax((int*)err, __float_as_int(fabsf(e))); atomicMax((int*)err + 1, __float_as_int(fabsf(ref)));
}
__device__ __forceinline__ float bsum(float v, float* red) {
    for (int o = 32; o > 0; o >>= 1) v += __shfl_xor(v, o);
    __syncthreads(); if ((threadIdx.x & 63) == 0) red[threadIdx.x >> 6] = v; __syncthreads();
    float t = 0.f; for (int i = 0; i < (int)(blockDim.x >> 6); ++i) t += red[i]; return t;
}
__global__ void set_tab(Ptrs p, const float** tab) { if (threadIdx.x < 24) tab[threadIdx.x] = p.in[threadIdx.x]; }
__global__ void zero_err(float* err) { for (int i = threadIdx.x; i < 256; i += blockDim.x) err[i] = 0.f; }
__global__ void encode(const float* err, float* out, size_t n, int slot) {
    float e = err[2 * slot] / fmaxf(err[2 * slot + 1], 1e-20f);
#ifdef MK_KEY
    { int am = 0; float best = -1.f, tot = 0.f; for (int s = 0; s < 32; ++s) { tot += err[64 + s]; if (err[64 + s] > best) { best = err[64 + s]; am = s; } }
      e = (slot == 0) ? (float)(1 + am) : (slot == 1 ? best / fmaxf(tot, 1.f) : tot * 1e-5f); }
#endif
    for (size_t i = (size_t)blockIdx.x * blockDim.x + threadIdx.x; i < n; i += (size_t)gridDim.x * blockDim.x) out[i] = 100000.f * e;
}
__global__ void gemm_rows(const unsigned short* A, int lda, int K, const float* W, int ldw, int N, float* Z, int ldz) {
    const int i = blockIdx.y, n = blockIdx.x * 256 + threadIdx.x; if (n >= N) return;
    const unsigned short* a = A + (size_t)srow(i) * lda; float s = 0.f;
    for (int k = 0; k < K; ++k) s += bf(a[k]) * W[(size_t)k * ldw + n];
    Z[(size_t)i * ldz + n] = s;
}
__device__ __forceinline__ float rope_val(const float* x  , int c, int d, int row) {
    const int half = d / 2, q = d / 4, axis = c / half, i = c % half, t = row & 4095, pos = axis ? (t & 63) : (t >> 6);
    const int ii = i % q; const float ang = (float)pos * powf(10000.f, -(float)(2 * ii) / (float)half); const float cs = cosf(ang), sn = sinf(ang);
    const float* xa = x + axis * half;
    return (i < q) ? xa[i] * cs - xa[i + q] * sn : xa[i] * cs + xa[i - q] * sn;
}
__global__ void cmp_p1(const float* Z, unsigned char* ws, float* err) {
    const int i = blockIdx.y, n = blockIdx.x * 256 + threadIdx.x; if (n >= 2848) return;
    const int row = srow(i); const bool lat = row < MLAT; const float* z = Z + (size_t)i * 5920; const float qs = 0.125f * LOG2E;
    float e; const unsigned short* o;
    if (n < 256) { e = z[n]; o = (unsigned short*)(ws + Q_CKVQ) + (size_t)row * 256 + n; }
    else if (n < 288) { const int c = n - 256; e = lat ? rope_val(z + 256, c, 32, row) : z[n]; o = (unsigned short*)(ws + Q_KR) + (size_t)row * 32 + c; }
    else if (n < 800) { const int c = n - 288, h = c / 64; e = lat ? rope_val(z + 288 + h * 64, c % 64, 64, row) : z[n]; o = (unsigned short*)(ws + Q_DK) + (size_t)row * 512 + c; }
    else if (n < 1312) { e = z[n]; o = (unsigned short*)(ws + Q_DV) + (size_t)row * 512 + (n - 800); }
    else if (n < 1440) { const int c = n - 1312, h = c / 64; e = lat ? rope_val(z + 1312 + h * 64, c % 64, 64, row) : z[n]; o = (unsigned short*)(ws + Q_SK) + (size_t)row * 128 + c; }
    else if (n < 1568) { e = z[n]; o = (unsigned short*)(ws + Q_SV) + (size_t)row * 128 + (n - 1440); }
    else if (n < 1824) { e = z[n]; o = (unsigned short*)(ws + Q_CKVQ) + (size_t)MALL * 256 + (size_t)row * 256 + (n - 1568); }
    else if (n < 2336) { const int c = n - 1824, h = c / 64; e = qs * (lat ? rope_val(z + 1824 + h * 64, c % 64, 64, row) : z[n]); o = (unsigned short*)(ws + Q_ABC) + (size_t)MALL * 512 + (size_t)row * 512 + c; }
    else { const int c = n - 2336, h = c / 64; e = qs * (lat ? rope_val(z + 2336 + h * 64, c % 64, 64, row) : z[n]); o = (unsigned short*)(ws + Q_ABC) + 2 * (size_t)MALL * 512 + (size_t)row * 512 + c; }
    upd(err, e - bf(*o), e);
}
__global__ void cmp_ss(const float* Z, unsigned char* ws, float* err) {
    const int i = blockIdx.x, which = threadIdx.x; if (which >= 2) return;
    const int row = srow(i); const float* z = Z + (size_t)i * 5920 + (which ? 1568 : 0); float s = 0.f;
    for (int k = 0; k < 256; ++k) s += z[k] * z[k];
    const float* S = (const float*)(ws + WS_SS) + (which ? (size_t)MALL * 4 : 0) + (size_t)row * 4;
    upd(err, s - (S[0] + S[1] + S[2] + S[3]), s);
}
__global__ void cmp_p2(const float* const* in, unsigned char* ws, float* err) {
    const int i = blockIdx.y, n = blockIdx.x * 256 + threadIdx.x; if (n >= 1792) return;
    const int row = srow(i); const bool lat = row < MLAT; const bool isq = n >= 1024;
    const unsigned short* a = (const unsigned short*)(ws + Q_CKVQ) + (isq ? (size_t)MALL * 256 : 0) + (size_t)row * 256;
    const float* S = (const float*)(ws + WS_SS) + (isq ? (size_t)MALL * 4 : 0) + (size_t)row * 4;
    const float rs = rsqrtf((S[0] + S[1] + S[2] + S[3]) / 256.f + EPS);
    const float* nw = isq ? in[11] : in[13]; const float* W = isq ? in[12] : in[14]; const int ldw = isq ? 768 : 1024;
    auto dot = [&](int col) { float s = 0.f; for (int k = 0; k < 256; ++k) s += bf(a[k]) * nw[k] * W[(size_t)k * ldw + col]; return s * rs; };
    float e; const unsigned short* o;
    if (!isq) { const int h = n / 128, j = n % 128; e = dot(n); o = (j < 64) ? (unsigned short*)(ws + Q_MK) + (size_t)row * 512 + h * 64 + j : (unsigned short*)(ws + Q_MV) + (size_t)row * 512 + h * 64 + (j - 64); }
    else { const int c = n - 1024, h = c / 96, j = c % 96; const float qs = 0.10206207261596575f * LOG2E;
        if (j < 64) { e = qs * dot(c); o = (unsigned short*)(ws + Q_ABC) + (size_t)row * 512 + h * 64 + j; }
        else { const int r = j - 64; float x;
            if (lat) { const int half = 16, q = 8, axis = r / half, ii = r % half, t = row & 4095, pos = axis ? (t & 63) : (t >> 6);
                const float ang = (float)pos * powf(10000.f, -(float)(2 * (ii % q)) / 16.f), cs = cosf(ang), sn = sinf(ang);
                const float me = dot(c), pa = dot(h * 96 + 64 + axis * half + (ii < q ? ii + q : ii - q));
                x = (ii < q) ? me * cs - pa * sn : me * cs + pa * sn; }
            else x = dot(c);
            e = qs * x; o = (unsigned short*)(ws + Q_QR) + (size_t)row * 256 + h * 32 + r; } }
    const int cat = !isq ? ((n % 128) < 64 ? 0 : 1) : (((n - 1024) % 96) < 64 ? 2 : 3);
    upd(err + 2 * cat, e - bf(*o), e);
}
__global__ void __launch_bounds__(64) cmp_attn(const float* const* in, unsigned char* ws, const unsigned short* obase, int layer, float* err) {
    __shared__ float sc[2][4352]; __shared__ float qs[96];
    const int i = blockIdx.x, h = blockIdx.y, type = blockIdx.z, lane = threadIdx.x;
    if (type == 1 && h >= 4) return;
    const int row = srow(i); const bool lat = row < MLAT; const int b = lat ? row >> 12 : (row - MLAT) >> 8, t = row & 4095;
    const int nkeys = lat ? 4352 : 256;
    auto krow = [&](int k) { return k < 256 ? MLAT + b * 256 + k : b * 4096 + (k - 256); };
    const unsigned short *QN = (unsigned short*)(ws + Q_ABC), *DQ = QN + (size_t)MALL * 512, *SQ = DQ + (size_t)MALL * 512, *QR = (unsigned short*)(ws + Q_QR), *MK = (unsigned short*)(ws + Q_MK), *MV = (unsigned short*)(ws + Q_MV),
                         *KR = (unsigned short*)(ws + Q_KR), *DK = (unsigned short*)(ws + Q_DK), *DV = (unsigned short*)(ws + Q_DV), *SK = (unsigned short*)(ws + Q_SK), *SV = (unsigned short*)(ws + Q_SV);
    float lsum[2] = {0.f, 0.f}; const int npass = type == 1 ? 2 : 1;
    for (int p = 0; p < npass; ++p) {
        __syncthreads();
        int dq = 64;
        if (type == 0) { for (int j = lane; j < 64; j += 64) qs[j] = bf(QN[(size_t)row * 512 + h * 64 + j]); if (lane < 32) qs[64 + lane] = bf(QR[(size_t)row * 256 + h * 32 + lane]); dq = 96; }
        else if (type == 1) qs[lane] = bf(DQ[(size_t)row * 512 + (2 * h + p) * 64 + lane]);
        else qs[lane] = bf(SQ[(size_t)row * 512 + h * 64 + lane]);
        __syncthreads();
        float mx = -INFINITY;
        for (int k = lane; k < nkeys; k += 64) {
            const int kr = krow(k); bool ok = true;
            if (type == 2 && k >= 256) { int dl = t - (k - 256); if (dl < 0) dl = -dl; ok = dl <= 128; }
            float s = -INFINITY;
            if (ok) { s = 0.f;
                if (type == 0) { for (int j = 0; j < 64; ++j) s += qs[j] * bf(MK[(size_t)kr * 512 + h * 64 + j]); for (int j = 0; j < 32; ++j) s += qs[64 + j] * bf(KR[(size_t)kr * 32 + j]); }
                else if (type == 1) { for (int j = 0; j < 64; ++j) s += qs[j] * bf(DK[(size_t)kr * 512 + (2 * h + p) * 64 + j]); }
                else { for (int j = 0; j < 64; ++j) s += qs[j] * bf(SK[(size_t)kr * 128 + (h >> 2) * 64 + j]); } }
            sc[p][k] = s; mx = fmaxf(mx, s);
        }
        const float sk2 = (type == 2) ? in[17][layer * 8 + h] * LOG2E : -INFINITY;
        mx = fmaxf(mx, sk2);
        for (int o = 32; o > 0; o >>= 1) mx = fmaxf(mx, __shfl_xor(mx, o));
        float sum = 0.f;
        for (int k = lane; k < nkeys; k += 64) { const float pv = exp2f(sc[p][k] - mx); sc[p][k] = pv; sum += pv; }
        for (int o = 32; o > 0; o >>= 1) sum += __shfl_xor(sum, o);
        if (type == 2) sum += exp2f(sk2 - mx);
        lsum[p] = sum; (void)dq;
    }
    __syncthreads();
    if (type != 1) {
        const unsigned short* V = type == 0 ? MV : SV; const int ldv = type == 0 ? 512 : 128, hoff = type == 0 ? h * 64 : (h >> 2) * 64;
        float acc = 0.f; for (int k = 0; k < nkeys; ++k) acc += sc[0][k] * bf(V[(size_t)krow(k) * ldv + hoff + lane]);
        const float e = acc / lsum[0]; const unsigned short* o = obase + (type == 0 ? 0 : 2) * (size_t)MALL * 512 + (size_t)row * 512 + h * 64 + lane;
        upd(err, e - bf(*o), e);
    } else {
        const float lam = *((const float*)(ws + WS_CTL) + CW_LAM + layer), lam_init = 0.8f - 0.6f * expf(-0.3f * (float)layer);
        float v[2]; float ss = 0.f;
        for (int j = 0; j < 2; ++j) { const int d = lane + 64 * j; float a0 = 0.f, a1 = 0.f;
            for (int k = 0; k < nkeys; ++k) { const float vv = bf(DV[(size_t)krow(k) * 512 + h * 128 + d]); a0 += sc[0][k] * vv; a1 += sc[1][k] * vv; }
            v[j] = a0 / lsum[0] - lam * a1 / lsum[1]; ss += v[j] * v[j]; }
        for (int o = 32; o > 0; o >>= 1) ss += __shfl_xor(ss, o);
        const float rs = rsqrtf(ss / 128.f + EPS);
        for (int j = 0; j < 2; ++j) { const int d = lane + 64 * j; const float e = v[j] * rs * in[16][layer * 128 + d] * (1.f - lam_init);
            const unsigned short* o = obase + (size_t)MALL * 512 + (size_t)row * 512 + h * 128 + d; upd(err, e - bf(*o), e); }
    }
}
__global__ void cmp_gates(const float* Z, unsigned char* ws, float* err) {
    const int i = blockIdx.y, n = blockIdx.x * 256 + threadIdx.x; if (n >= 3072) return;
    const float e = 1.f / (1.f + expf(-Z[(size_t)i * 3072 + n])); const unsigned short* o = (const unsigned short*)(ws + Q_G) + (size_t)srow(i) * 3072 + n;
    { const int row = srow(i); const bool bad = fabsf(e - bf(*o)) > 0.02f;
#ifndef MK_KEY
#define MK_KEY 0
#endif
      const int key = MK_KEY == 0 ? (n % 256) / 8 : MK_KEY == 1 ? (row % 256) / 8 : MK_KEY == 2 ? (row % 16) : MK_KEY == 3 ? (n % 32) : (n / 256);
      if (bad) atomicAdd(err + 64 + key, 1.0f); }
}
__global__ void cmp_merge(const float* const* in, unsigned char* ws, int layer, float* err) {
    const int i = blockIdx.y, n = blockIdx.x * 256 + threadIdx.x, row = srow(i); float e = 0.f;
    for (int br = 0; br < 3; ++br) { const unsigned short* a = (const unsigned short*)(ws + Q_ABC) + (size_t)br * MALL * 512 + (size_t)row * 512; const float* W = in[18 + br] + (size_t)layer * 512 * 1024; float s = 0.f;
        for (int k = 0; k < 512; ++k) s += bf(a[k]) * W[(size_t)k * 1024 + n];
        e += bf(*((const unsigned short*)(ws + Q_G) + (size_t)row * 3072 + br * 1024 + n)) * s; }
    upd(err, e - bf(*((const unsigned short*)(ws + WS_H) + (size_t)row * 1024 + n)), e);
}
__global__ void cmp_f32(const float* Z, int ldz, const float* Y, int ldy, int N, float* err) {
    const int i = blockIdx.y, n = blockIdx.x * 256 + threadIdx.x; if (n >= N) return;
    const float e = Z[(size_t)i * ldz + n]; upd(err, e - Y[(size_t)srow(i) * ldy + n], e);
}
__global__ void cmp_act(const float* Z, unsigned char* ws, float* err) {
    const int i = blockIdx.y, n = blockIdx.x * 256 + threadIdx.x; if (n >= 2816) return;
    const float g = Z[(size_t)i * 5632 + n], u = Z[(size_t)i * 5632 + 2816 + n], e = g / (1.f + expf(-g)) * u;
    upd(err, e - bf(*((const unsigned short*)(ws + Q_ACT) + (size_t)srow(i) * 2816 + n)), e);
}
__global__ void __launch_bounds__(256) cmp_rowpost(const float* const* in, unsigned char* ws, const float* outp, int layer, int which  , float* err) {
    __shared__ float red[8]; __shared__ float xs[1024];
    const int i = blockIdx.x, row = srow(i); const bool lat = row < MLAT; const int cond = lat ? row >> 12 : 4;
    const float* mods = (const float*)(ws + WS_CTL) + CW_MODS + ((size_t)layer * 5 + cond) * 6144;
    const float* y = (which == 1 ? (const float*)(ws + Q_Y) : (const float*)(ws + Q_F2)) + (size_t)row * 1024;
    (void)y; (void)mods; (void)red; (void)xs; (void)in; (void)outp; (void)err;
    if (which != 1 || layer != 0) return;
    const float* res = lat ? in[0] + (size_t)row * 1024 : in[2] + (size_t)(row - MLAT) * 1024;
    float ss = 0.f; for (int j = threadIdx.x; j < 1024; j += 256) ss += y[j] * y[j];
    ss = bsum(ss, red); const float rs = rsqrtf(ss / 1024.f + EPS);
    float s2 = 0.f;
    for (int j = threadIdx.x; j < 1024; j += 256) { const float x1 = res[j] + mods[2 * 1024 + j] * (y[j] * rs * in[7][layer * 1024 + j]); xs[j] = x1; s2 += x1 * x1;
        const float o = lat ? outp[(size_t)row * 1024 + j] : *((const float*)(ws + WS_CTXRES) + (size_t)(row - MLAT) * 1024 + j); upd(err, x1 - o, x1); }
    s2 = bsum(s2, red); const float r2 = rsqrtf(s2 / 1024.f + EPS);
    for (int j = threadIdx.x; j < 1024; j += 256) { const float hh = (xs[j] * r2 * in[8][layer * 1024 + j]) * (1.f + mods[4 * 1024 + j]) + mods[3 * 1024 + j];
        upd(err + 2, hh - bf(*((const unsigned short*)(ws + WS_H) + (size_t)row * 1024 + j)), hh); }
}
}
#endif


#ifndef MK_SIG_ALIGN
#define MK_SIG_ALIGN true
#endif
#ifndef MK_SIG_SP2
#define MK_SIG_SP2 true
#endif
#ifndef MK_STOP_AFTER
#define MK_STOP_AFTER 1000
#endif
__global__ void __launch_bounds__(NWAVES * 64, 2) mk_fwd(Ptrs P) {
    extern __shared__ __attribute__((aligned(16))) unsigned char lds_raw[];
    LAS unsigned char* lds = (LAS unsigned char*)lds_raw;
    volatile LAS unsigned* MISC = (volatile LAS unsigned*)(lds + MISC_OFF);
    volatile LAS unsigned long long* PT = (volatile LAS unsigned long long*)(lds + MISC_OFF + 256);
#define IN(i) ((const float*)PT[i])
#define OUTP ((float*)PT[24])
    const int tid = threadIdx.x, wave0 = __builtin_amdgcn_readfirstlane(tid >> 6);
    const int G = gridDim.x, bx = blockIdx.x, vcu = (G % 8 == 0) ? (bx % 8) * (G / 8) + bx / 8 : bx;
    unsigned char* ws = P.ws;
    gu32* ctl = (gu32*)(ws + WS_CTL);
    for (int u = tid; u < (LDS_BYTES - LDSCTL_OFF) / 4; u += NWAVES * 64) ((LAS unsigned*)(lds + LDSCTL_OFF))[u] = 0u;
    __syncthreads();
    if (tid == 0) {
#pragma unroll
        for (int i = 0; i < 24; ++i) PT[i] = (unsigned long long)P.in[i];
        PT[24] = (unsigned long long)P.out;
    }
    __syncthreads();
    (void)xcd_barrier_post((unsigned*)(ctl + CW_BAR), MISC + 8);
    int phase_no = 0;
#define GRID_BAR() do { unsigned char* wsb = ws; asm volatile("" : "+s"(wsb)); int wvb = wave0; asm volatile("" : "+s"(wvb)); XcdBarrier bar_; bar_.bar = (unsigned*)(wsb + WS_CTL) + CW_BAR; bar_.x = xb_xcc_id(); bar_.st = MISC + 8; \
        int lnb; asm volatile("v_mbcnt_lo_u32_b32 %0, -1, 0\n\tv_mbcnt_hi_u32_b32 %0, -1, %0" : "=v"(lnb)); const bool t0_ = (wvb == 0) && (lnb == 0); xcd_barrier(bar_, t0_); if (++phase_no >= MK_STOP_AFTER) goto dump_and_exit; } while (0)

#define PH_BEGIN() unsigned char* wsp = ws; asm volatile("" : "+s"(wsp)); int lane; asm volatile("v_mbcnt_lo_u32_b32 %0, -1, 0\n\tv_mbcnt_hi_u32_b32 %0, -1, %0" : "=v"(lane)); int wave = wave0; asm volatile("" : "+s"(wave)); \
    float* MODS = (float*)(wsp + WS_CTL) + CW_MODS; float* LAMS = (float*)(wsp + WS_CTL) + CW_LAM; float* TAB = (float*)(wsp + WS_CTL) + CW_TAB; \
    bf16* Hb = (bf16*)(wsp + WS_H); bf16* QN = (bf16*)(wsp + Q_ABC); bf16* DQ = QN + (size_t)MALL * 512; bf16* SQ = DQ + (size_t)MALL * 512; \
    bf16* QR = (bf16*)(wsp + Q_QR); bf16* MK = (bf16*)(wsp + Q_MK); bf16* MV = (bf16*)(wsp + Q_MV); bf16* KR = (bf16*)(wsp + Q_KR); \
    bf16* DK = (bf16*)(wsp + Q_DK); bf16* DV = (bf16*)(wsp + Q_DV); bf16* SK = (bf16*)(wsp + Q_SK); bf16* SV = (bf16*)(wsp + Q_SV); \
    bf16* CKV = (bf16*)(wsp + Q_CKVQ); bf16* CQ = CKV + (size_t)MALL * 256; \
    bf16* GT = (bf16*)(wsp + Q_G); float* Yb = (float*)(wsp + Q_Y); bf16* ACT = (bf16*)(wsp + Q_ACT); float* F2 = (float*)(wsp + Q_F2); \
    float* CTXRES = (float*)(wsp + WS_CTXRES); float* SSKV = (float*)(wsp + WS_SS); float* SSQ = SSKV + (size_t)MALL * 4; \
    unsigned char* wsW = wsp + WS_W; const int gw = vcu * NWAVES + wave, NGW = G * NWAVES; \
    (void)MODS; (void)LAMS; (void)TAB; (void)Hb; (void)QN; (void)DQ; (void)SQ; (void)QR; (void)MK; (void)MV; (void)KR; (void)DK; (void)DV; (void)SK; (void)SV; (void)CKV; (void)CQ; (void)GT; (void)Yb; (void)ACT; (void)F2; (void)CTXRES; (void)SSKV; (void)SSQ; (void)wsW; (void)gw; (void)NGW; (void)lane; (void)wave

    {
        PH_BEGIN();
        for (int it = gw; it < 2 * 24 * 32; it += NGW) adaln_item(PT, it, (float*)(wsp + WS_QKV), lane);
        convert_weights(PT, 0, wsW, (LAS float*)(lds + wave * 16384), gw, NGW, lane);
        if (bx == 0) {
            if (wave == 0 && lane < 2) {
                const float* dl = IN(15) + lane * 256; float a = 0.f, b = 0.f;
                for (int i = 0; i < 64; ++i) { a += dl[i] * dl[64 + i]; b += dl[128 + i] * dl[192 + i]; }
                LAMS[lane] = expf(a) - expf(b) + (0.8f - 0.6f * expf(-0.3f * (float)lane));
            }
            const int tid_l = wave * 64 + lane;
            for (int e = tid_l; e < 64 * 16; e += NWAVES * 64) { const int pos = e >> 4, i = e & 15; const float ang = (float)pos * powf(10000.f, -(float)(2 * i) / 32.f); TAB[e] = cosf(ang); TAB[1024 + e] = sinf(ang); }
            for (int e = tid_l; e < 64 * 8; e += NWAVES * 64) { const int pos = e >> 3, i = e & 7; const float ang = (float)pos * powf(10000.f, -(float)(2 * i) / 16.f); TAB[2048 + e] = cosf(ang); TAB[2560 + e] = sinf(ang); }
        }
    }
    GRID_BAR();
    { PH_BEGIN();
      const float* part = (const float*)(wsp + WS_QKV); const float* bias = IN(5);
      for (int e = gw * 64 + lane; e < 2 * 5 * 6144; e += NGW * 64) { const int l = e / (5 * 6144), r = e - l * 5 * 6144, c = r / 6144, n = r - c * 6144;
          float s = *(const GAS float*)(bias + l * 6144 + n);
          for (int kc = 0; kc < 32; ++kc) s += *(const GAS float*)(part + (((size_t)l * 32 + kc) * 5 + c) * 6144 + n);
          *(GAS float*)(MODS + e) = s; } }
    GRID_BAR();
    { PH_BEGIN();
    for (int row = gw; row < MALL; row += NGW) {
        const bool lat = row < MLAT; const float* xr = lat ? IN(0) + (size_t)row * DM : IN(2) + (size_t)(row - MLAT) * DM;
        const float* md = MODS + (size_t)(lat ? (row >> 12) : 4) * 6144;
        f32x4 x[4];
#pragma unroll
        for (int j = 0; j < 4; ++j) x[j] = *(const GAS f32x4*)(xr + 4 * lane + 256 * j);
        row_prenorm(x, IN(6), md, md + DM, Hb + (size_t)row * DM, lane);
    } }
    GRID_BAR();

    for (int l = 0; l < 2; ++l) {
        const bool last = (l == 1);
        const int npan = last ? PAN_LAT : PAN_ALL;
        const float lam_init = 0.8f - 0.6f * expf(-0.3f * (float)l);
        {
            PH_BEGIN();
            pg8::Gemm g{Hb, (const bf16*)(wsW + W_IN), DM};
            pg8::Sched S{PAN_LAT, 12, 4, last ? 7 : 12, 0, 0, PAN_LAT, 0, PAN_LAT, 1, 0, 0, G, bx};
            pg8::EpiP1 E{CKV, CQ, KR, DK, DV, SK, SV, DQ, SQ, SSKV, SSQ, TAB, 0.125f * LOG2E};
#ifndef MK_NO_P1
            pg8::gemm_phase<pg8::EpiP1, pg8::Sched, false, true>(lds, g, S, E, wave, lane);
#endif
        }
        GRID_BAR();
        {
            PH_BEGIN();
            pg8::Gemm g{CKV, (const bf16*)(wsW + W_UKVQ), 256};
            pg8::Sched S{PAN_ALL, 4, npan, 3, 0, 0, PAN_ALL, 4, 0, 1, 0, 0, G, bx};
            pg8::EpiP2 E{MK, MV, QN, QR, SSKV, SSQ, TAB, 0.10206207261596575f * LOG2E, EPS};
#ifndef MK_NO_P2
            pg8::gemm_phase<pg8::EpiP2, pg8::Sched, false, true>(lds, g, S, E, wave, lane);
#endif
        }
        GRID_BAR();
        {
            PH_BEGIN();
            #ifdef MK_ATT_OUT_DOUT
            bf16* OAd = (bf16*)OUTP; att::Bufs B{QN, QR, MK, MV, KR, DQ, DK, DV, SQ, SK, SV, OAd, OAd + (size_t)MALL * 512, OAd + 2 * (size_t)MALL * 512, LAMS + l, IN(16) + l * 128, IN(17) + l * 8, lam_init, EPS};
#else
            att::Bufs B{QN, QR, MK, MV, KR, DQ, DK, DV, SQ, SK, SV, QN, DQ, SQ, LAMS + l, IN(16) + l * 128, IN(17) + l * 8, lam_init, EPS};
#endif
            LAS unsigned char* al = lds;
#ifndef MK_NO_DIFF
            for (int u = vcu; u < 256; u += G) att::attn_unit(al, B, 1, u >> 6, (u >> 4) & 3, u & 15, wave, lane);
#endif
#ifndef MK_NO_MLA
            for (int u = vcu; u < 512; u += G) att::attn_unit(al, B, 0, u >> 7, (u >> 4) & 7, u & 15, wave, lane);
#endif
#ifndef MK_NO_SWA
            for (int u = vcu; u < 512; u += G) att::attn_unit(al, B, 2, u >> 7, (u >> 4) & 7, u & 15, wave, lane);
#endif
            if (!last) {
#ifndef MK_NO_CTXQ
                for (int u = vcu; u < 80; u += G) {
                    if (u < 32) att::attn_unit(al, B, 0, u >> 3, u & 7, 16, wave, lane);
                    else if (u < 48) att::attn_unit(al, B, 1, (u - 32) >> 2, (u - 32) & 3, 16, wave, lane);
                    else att::attn_unit(al, B, 2, (u - 48) >> 3, (u - 48) & 7, 16, wave, lane);
                }
#endif
            }
        }
        GRID_BAR();
        {
            PH_BEGIN();
            pg8::Gemm g{Hb, (const bf16*)(wsW + W_G), DM};
            pg8::Sched S{npan, 12, 0, 0, 0, 0, 0, 0, 0, 1, 0, 0, G, bx};
            pg8::EpiSig E{GT};
#ifndef MK_NO_P3B
            pg8::gemm_phase<pg8::EpiSig, pg8::Sched, false, true>(lds, g, S, E, wave, lane);
#endif
        }
        GRID_BAR();
        {
            PH_BEGIN();
            pg8::Gemm g{QN, (const bf16*)(wsW + W_ABC), 512};
            pg8::Sched S{npan, 4, 0, 0, 0, 0, 0, 0, 0, 3, PAN_ALL, 4, G, bx};
            pg8::EpiMerge E{GT, Hb};
#ifndef MK_NO_P4A
            pg8::gemm_phase<pg8::EpiMerge, pg8::Sched, false, true>(lds, g, S, E, wave, lane);
#endif
        }
        GRID_BAR();
        {
            PH_BEGIN();
            pg8::Gemm g{Hb, (const bf16*)(wsW + W_O), DM};
            pg8::Sched S{npan, 4, 0, 0, 0, 0, 0, 0, 0, 1, 0, 0, G, bx};
            pg8::EpiF32 E{Yb, DM};
#ifndef MK_NO_PF32
            pg8::gemm_phase<pg8::EpiF32, pg8::Sched, false, true>(lds, g, S, E, wave, lane);
#endif
        }
        GRID_BAR();
        { PH_BEGIN(); const float* mods_l = MODS + (size_t)l * 5 * 6144;
        for (int row = gw; row < npan * 256; row += NGW) {
            const bool lat = row < MLAT; const float* md = mods_l + (size_t)(lat ? (row >> 12) : 4) * 6144;
            const float* res = lat ? ((l == 0 ? IN(0) : (const float*)OUTP) + (size_t)row * DM) : ((l == 0 ? IN(2) : (const float*)CTXRES) + (size_t)(row - MLAT) * DM);
            float* ro = lat ? OUTP + (size_t)row * DM : CTXRES + (size_t)(row - MLAT) * DM;
            row_post(res, Yb + (size_t)row * DM, IN(7) + l * DM, md + 2 * DM, ro, IN(8) + l * DM, md + 3 * DM, md + 4 * DM, Hb + (size_t)row * DM, lane);
        } }
        GRID_BAR();
        {
            PH_BEGIN();
            pg8::Gemm g{Hb, (const bf16*)(wsW + W_GU), DM};
            pg8::Sched S{npan, 22, 0, 0, 0, 0, 0, 0, 0, 1, 0, 0, G, bx};
            pg8::EpiSwiglu E{ACT};
#ifndef MK_NO_P5
            pg8::gemm_phase<pg8::EpiSwiglu, pg8::Sched, false, true>(lds, g, S, E, wave, lane);
#endif
        }
        GRID_BAR();
        {
            PH_BEGIN();
            pg8::Gemm g{ACT, (const bf16*)(wsW + W_DN), DFF};
            pg8::Sched S{npan, 4, 0, 0, 0, 0, 0, 0, 0, 1, 0, 0, G, bx};
            pg8::EpiF32 E{F2, DM};
#ifndef MK_NO_PF32
            pg8::gemm_phase<pg8::EpiF32, pg8::Sched, false, true>(lds, g, S, E, wave, lane);
#endif
        }
        GRID_BAR();
        {
            PH_BEGIN(); const float* mods_l = MODS + (size_t)l * 5 * 6144;
            const float* mods_n = MODS + (size_t)(l + 1) * 5 * 6144;
            for (int row = gw; row < npan * 256; row += NGW) {
                const bool lat = row < MLAT; const int cond = lat ? (row >> 12) : 4; const float* md = mods_l + (size_t)cond * 6144; const float* mn = mods_n + (size_t)cond * 6144;
                float* ro = lat ? OUTP + (size_t)row * DM : CTXRES + (size_t)(row - MLAT) * DM;
                row_post(ro, F2 + (size_t)row * DM, IN(9) + l * DM, md + 5 * DM, ro, IN(6) + (l + 1) * DM, mn, mn + DM, last ? nullptr : Hb + (size_t)row * DM, lane);
            }
            if (!last) convert_weights(PT, l + 1, wsW, (LAS float*)(lds + wave * 16384), gw, NGW, lane);
        }
        if (!last) GRID_BAR();
    }
    if (false) {
dump_and_exit:
#ifdef MK_DUMP_LO
        { unsigned char* wsd = ws; asm volatile("" : "+s"(wsd)); int ln; asm volatile("v_mbcnt_lo_u32_b32 %0, -1, 0\n\tv_mbcnt_hi_u32_b32 %0, -1, %0" : "=v"(ln));
          const unsigned* src = (const unsigned*)(wsd + (size_t)(MK_DUMP_LO)); const size_t nw = ((size_t)(MK_DUMP_HI) - (size_t)(MK_DUMP_LO)) / 4; float* o = OUTP;
          const size_t NO = (size_t)MLAT * DM;
          if (nw > 0) for (size_t j = (size_t)bx * 512 + wave0 * 64 + ln; j < NO; j += (size_t)G * 512) { unsigned x = 0u; for (size_t q = j; q < nw; q += NO) x ^= src[q]; x ^= x >> 16; o[j] = (float)(x & 0xffffu) * (1.0f / 65536.0f); } }
#endif
        return;
    }
    { unsigned char* wsb = ws; asm volatile("" : "+s"(wsb)); const unsigned tmo = __hip_atomic_load((unsigned*)(wsb + WS_CTL) + CW_BAR + XB_TMO, __ATOMIC_RELAXED, __HIP_MEMORY_SCOPE_AGENT);
      if (tmo != 0u && bx == 0 && wave0 == 0) { float* o = OUTP; o[0] = 3.0e7f; } }
}

extern "C" void kernel_launch(void* const* d_in, const int* in_sizes, int n_in, void* d_out, int out_size, void* d_ws, size_t ws_size, hipStream_t stream) {
    static int grid = 0;
    if (grid == 0) {
        if (n_in != 24 || out_size != MLAT * DM || ws_size < WS_END) { fprintf(stderr, "kernel_launch: unexpected shapes (n_in %d out %d ws %zu need %zu)\n", n_in, out_size, ws_size, (size_t)WS_END); grid = -1; return; }
        int dev = 0, cus = 0, per_cu = 0;
        (void)hipGetDevice(&dev); (void)hipDeviceGetAttribute(&cus, hipDeviceAttributeMultiprocessorCount, dev);
        if (hipFuncSetAttribute((const void*)mk_fwd, hipFuncAttributeMaxDynamicSharedMemorySize, LDS_BYTES) != hipSuccess) { fprintf(stderr, "kernel_launch: hipFuncSetAttribute failed\n"); grid = -1; return; }
        (void)hipOccupancyMaxActiveBlocksPerMultiprocessor(&per_cu, (const void*)mk_fwd, NWAVES * 64, LDS_BYTES);
        (void)hipGetLastError();
        if (per_cu < 1) fprintf(stderr, "kernel_launch: occupancy query says %d blocks/CU\n", per_cu);
        grid = cus;
    }
    if (grid < 0) return;
    (void)hipMemsetAsync((char*)d_ws + WS_CTL, 0, CTL_BYTES, stream);
    Ptrs p{};
    for (int i = 0; i < 24; ++i) p.in[i] = (const float*)d_in[i];
    p.out = (float*)d_out; p.ws = (unsigned char*)d_ws;
    hipLaunchKernelGGL(mk_fwd, dim3(grid), dim3(NWAVES * 64), LDS_BYTES, stream, p);
#ifdef MK_CHECK
    {
#ifndef MK_CHECK_LAYER
#define MK_CHECK_LAYER 0
#endif
#ifndef MK_CHECK_SLOT
#define MK_CHECK_SLOT 0
#endif
        constexpr int L = MK_CHECK_LAYER; unsigned char* ws = (unsigned char*)d_ws;
        float* err = (float*)(ws + 240 * MiB); const float** tab = (const float**)(ws + 240 * MiB + 4096); float* Z = (float*)d_out;
        const float* w_in = (const float*)d_in[10] + (size_t)L * DM * INW;
        chk::set_tab<<<1, 32, 0, stream>>>(p, tab); chk::zero_err<<<1, 64, 0, stream>>>(err);
#if MK_CHECK == 1
        chk::gemm_rows<<<dim3(24, chk::NS), 256, 0, stream>>>((const unsigned short*)(ws + WS_H), 1024, 1024, w_in, INW, INW, Z, INW);
        chk::cmp_p1<<<dim3(12, chk::NS), 256, 0, stream>>>(Z, ws, err); chk::cmp_ss<<<chk::NS, 64, 0, stream>>>(Z, ws, err + 2);
#elif MK_CHECK == 2
        chk::cmp_p2<<<dim3(7, chk::NS), 256, 0, stream>>>(tab, ws, err);
#elif MK_CHECK == 3
        chk::cmp_attn<<<dim3(chk::NS, 8, 3), 64, 0, stream>>>(tab, ws, (const unsigned short*)d_out, L, err);
#elif MK_CHECK == 4
        chk::gemm_rows<<<dim3(12, chk::NS), 256, 0, stream>>>((const unsigned short*)(ws + WS_H), 1024, 1024, w_in + 2848, INW, 3072, Z, 3072);
        chk::cmp_gates<<<dim3(12, chk::NS), 256, 0, stream>>>(Z, ws, err);
#elif MK_CHECK == 5
        chk::cmp_merge<<<dim3(4, chk::NS), 256, 0, stream>>>(tab, ws, L, err);
#elif MK_CHECK == 6
        chk::gemm_rows<<<dim3(4, chk::NS), 256, 0, stream>>>((const unsigned short*)(ws + WS_H), 1024, 1024, (const float*)d_in[21] + (size_t)L * DM * DM, DM, DM, Z, DM);
        chk::cmp_f32<<<dim3(4, chk::NS), 256, 0, stream>>>(Z, DM, (const float*)(ws + Q_Y), DM, DM, err);
#elif MK_CHECK == 7
        chk::cmp_rowpost<<<chk::NS, 256, 0, stream>>>(tab, ws, (const float*)d_out, L, 1, err);
#elif MK_CHECK == 8
        chk::gemm_rows<<<dim3(22, chk::NS), 256, 0, stream>>>((const unsigned short*)(ws + WS_H), 1024, 1024, (const float*)d_in[22] + (size_t)L * DM * 2 * DFF, 2 * DFF, 2 * DFF, Z, 2 * DFF);
        chk::cmp_act<<<dim3(11, chk::NS), 256, 0, stream>>>(Z, ws, err);
#elif MK_CHECK == 9
        chk::gemm_rows<<<dim3(4, chk::NS), 256, 0, stream>>>((const unsigned short*)(ws + Q_ACT), DFF, DFF, (const float*)d_in[23] + (size_t)L * DFF * DM, DM, DM, Z, DM);
        chk::cmp_f32<<<dim3(4, chk::NS), 256, 0, stream>>>(Z, DM, (const float*)(ws + Q_F2), DM, DM, err);
#endif
        chk::encode<<<1024, 256, 0, stream>>>(err, (float*)d_out, (size_t)MLAT * DM, MK_CHECK_SLOT);
    }
#endif
}
```

```cpp
#include <hip/hip_runtime.h>
#include <cstdio>
#include <cstdint>
#include <math.h>
namespace pg8 {
#define PG8_LAS __attribute__((address_space(3)))
typedef unsigned short bf16_t;
typedef short bf16x8 __attribute__((ext_vector_type(8)));
typedef float f32x4 __attribute__((ext_vector_type(4)));
typedef unsigned u32x4 __attribute__((ext_vector_type(4)));
constexpr int BM = 256, BK = 64, HALF = 128, HTB = HALF * BK * 2  , STAGE_BYTES = 8 * HTB, NXCD = 8, WGM = 8;

__host__ __device__ __forceinline__ int lds_byte(int r, int c) { const int st = (r >> 4) * 2 + (c >> 5), rr = r & 15, cc = c & 31, ob = rr * 64 + cc * 2; return st * 1024 + (ob ^ (((ob >> 9) & 1) << 5)); }
__host__ __device__ __forceinline__ void stage_rc(int b, int& R, int& C) { const int st = b / 1024, sb = b % 1024, swz = sb ^ (((sb >> 9) & 1) << 5); R = (st >> 1) * 16 + swz / 64; C = (st & 1) * 32 + (swz % 64) / 2; }
__host__ __device__ __forceinline__ int perm32(int rho) { const int n = rho >> 4, i = rho & 15; return 8 * (i >> 2) + 4 * n + (i & 3); }

struct Unit { int pm, pn, rm, rn, aux; };
struct Gemm { const bf16_t* A; const bf16_t* Bt; int K; };

__device__ __forceinline__ void tile_of(int L, int nM, int nN, int& pm, int& pn) {
    const int nwg = nM * nN; int wgid = L;
    { const int q = nwg / NXCD, r = nwg % NXCD, xcd = wgid % NXCD, off = wgid / NXCD; wgid = (xcd < r ? xcd * (q + 1) : r * (q + 1) + (xcd - r) * q) + off; }
    const int nig = WGM * nN, gid = wgid / nig, fm = gid * WGM, gsz = (nM - fm) < WGM ? (nM - fm) : WGM;
    pm = fm + ((wgid % nig) % gsz); pn = (wgid % nig) / gsz;
}
struct Sched {
    int nMa, nNa, nMb, nNb;
    int pmA, pnA, pmB, pnB;
    int rmB;
    int rep, repM, repN;
    int G, c;
    __device__ __forceinline__ bool next(int i, Unit& u) const {
        const int ti = (rep == 1) ? i : i / rep, br = i - ti * rep;
        const int L = ti * G + c, na = nMa * nNa, nb = nMb * nNb;
        if (L >= na + nb) return false;
        int pm, pn;
        if (L < na) { tile_of(L, nMa, nNa, pm, pn); u.rm = pm; u.rn = pn; u.pm = pmA + pm + br * repM; u.pn = pnA + pn + br * repN; u.aux = br; }
        else { tile_of(L - na, nMb, nNb, pm, pn); u.rm = rmB + pm; u.rn = pn; u.pm = pmB + pm + br * repM; u.pn = pnB + pn + br * repN; u.aux = br | 0x100; }
        return true;
    }
    __device__ __forceinline__ void a_ready(const Unit&) const {}
    __device__ __forceinline__ void done(const Unit&) const {}
};

typedef float f32x2_t __attribute__((ext_vector_type(2))); typedef __bf16 bf16x2_t __attribute__((ext_vector_type(2)));
__device__ __forceinline__ unsigned cvt_pk_bf16(float lo, float hi) { f32x2_t v = {lo, hi}; bf16x2_t b = __builtin_convertvector(v, bf16x2_t); return __builtin_bit_cast(unsigned, b); }
typedef unsigned u32x2 __attribute__((ext_vector_type(2)));

#define PG8_GAS __attribute__((address_space(1)))
__device__ __forceinline__ void gst16(void* p, u32x4 v) { *(PG8_GAS u32x4*)p = v; }
__device__ __forceinline__ void gst8(void* p, unsigned a, unsigned b) { typedef unsigned u2 __attribute__((ext_vector_type(2))); *(PG8_GAS u2*)p = (u2){a, b}; }
__device__ __forceinline__ void gstf4(void* p, f32x4 v) { *(PG8_GAS f32x4*)p = v; }
__device__ __forceinline__ f32x4 gldf4(const void* p) { return *(const PG8_GAS f32x4*)p; }
__device__ __forceinline__ u32x4 gld16(const void* p) { return *(const PG8_GAS u32x4*)p; }
__device__ __forceinline__ float bf_lo(unsigned w) { return __uint_as_float(w << 16); }
__device__ __forceinline__ float bf_hi(unsigned w) { return __uint_as_float(w & 0xffff0000u); }
__device__ __forceinline__ float fast_sigmoid(float x) { return __builtin_amdgcn_rcpf(1.f + __builtin_amdgcn_exp2f(-1.4426950408889634f * x)); }


struct EpiP1 {
    static constexpr bool PERM = false, AFTER_DRAIN = false;
    bf16_t *CKV, *CQ, *KR, *DK, *DV, *SK, *SV, *DQ, *SQ; float *SSKV, *SSQ; const float* TAB; float qscale;
    __device__ __forceinline__ void operator()(const f32x4 (&acc)[2][2][4][2], const Unit& u, int wr, int wc, int fr, int fq) const {
        const bool lat = u.rm < 64;
        const int row0 = u.rm * BM + wr * 64 + fr;
        float ss[2][4];
#pragma unroll
        for (int ai = 0; ai < 2; ++ai)
#pragma unroll
            for (int m = 0; m < 4; ++m) ss[ai][m] = 0.f;
        int kind = 0;
#pragma unroll
        for (int bj = 0; bj < 2; ++bj) {
            const int rn = u.rn;
            const bool isq = rn >= 8;
            bf16_t* dst = (rn == 0) ? CKV : (rn == 1 || rn == 2) ? DK : (rn == 3 || rn == 4) ? DV : (rn == 5) ? (bj ? SV : SK) : (rn == 6) ? KR : (rn == 7) ? CQ : (rn == 8 || rn == 9) ? DQ : SQ;
            const int ld = (rn == 0 || rn == 7) ? 256 : (rn == 5) ? 128 : (rn == 6) ? 32 : 512;
            const int col = (rn == 5 || rn == 6) ? 0 : (((rn == 2 || rn == 4 || rn == 9 || rn == 11) ? 256 : 0) + 128 * bj);
            kind = (rn == 0 || rn == 7) ? 2 : (rn == 3 || rn == 4) ? 0 : (rn == 5) ? (bj ? 0 : 1) : (rn == 6) ? (bj ? 4 : 3) : 1;
            const float scale = isq ? qscale : 1.f;
            if (kind == 4) continue;
            if (kind == 3) {
                if (wc != 0) continue;
#pragma unroll
                for (int ai = 0; ai < 2; ++ai)
#pragma unroll
                    for (int m = 0; m < 4; ++m) {
                        const int row = row0 + ai * HALF + m * 16;
                        f32x4 x0 = acc[ai][bj][m][0], x1 = acc[ai][bj][m][1];
                        if (lat) {
                            f32x4 o0, o1;
#pragma unroll
                            for (int j = 0; j < 4; ++j) { o0[j] = __shfl_xor(x0[j], 32); o1[j] = __shfl_xor(x1[j], 32); }
                            const int pr = (row >> 6) & 63, pc = row & 63, ib = 4 * (fq & 1);
                            const f32x4 cr = gldf4(TAB + 2048 + pr * 8 + ib), sr = gldf4(TAB + 2560 + pr * 8 + ib);
                            const f32x4 cc = gldf4(TAB + 2048 + pc * 8 + ib), sc = gldf4(TAB + 2560 + pc * 8 + ib);
                            if (fq < 2) { x0 = x0 * cr - o0 * sr; x1 = x1 * cc - o1 * sc; } else { x0 = x0 * cr + o0 * sr; x1 = x1 * cc + o1 * sc; }
                        }
                        u32x2 w0, w1; w0.x = cvt_pk_bf16(x0[0], x0[1]); w0.y = cvt_pk_bf16(x0[2], x0[3]); w1.x = cvt_pk_bf16(x1[0], x1[1]); w1.y = cvt_pk_bf16(x1[2], x1[3]);
                        bf16_t* p = dst + (size_t)row * 32 + 4 * fq; gst8(p, w0.x, w0.y); gst8(p + 16, w1.x, w1.y);
                    }
                continue;
            }
            const bool rope = (kind == 1) && lat;
#pragma unroll
            for (int ai = 0; ai < 2; ++ai)
#pragma unroll
                for (int m = 0; m < 4; ++m) {
                    const int row = row0 + ai * HALF + m * 16;
                    f32x4 x0 = acc[ai][bj][m][0], x1 = acc[ai][bj][m][1];
                    if (kind == 2) { ss[ai][m] += (x0[0] * x0[0] + x0[1] * x0[1]) + (x0[2] * x0[2] + x0[3] * x0[3]) + (x1[0] * x1[0] + x1[1] * x1[1]) + (x1[2] * x1[2] + x1[3] * x1[3]); }
                    if (rope) {
                        const int pos = (wc & 1) ? (row & 63) : ((row >> 6) & 63);
                        const f32x4 c4 = gldf4(TAB + pos * 16 + 4 * fq), s4 = gldf4(TAB + 1024 + pos * 16 + 4 * fq);
                        const f32x4 y0 = x0 * c4 - x1 * s4, y1 = x1 * c4 + x0 * s4; x0 = y0; x1 = y1;
                    }
                    x0 = x0 * scale; x1 = x1 * scale;
                    u32x2 w0, w1; w0.x = cvt_pk_bf16(x0[0], x0[1]); w0.y = cvt_pk_bf16(x0[2], x0[3]); w1.x = cvt_pk_bf16(x1[0], x1[1]); w1.y = cvt_pk_bf16(x1[2], x1[3]);
                    bf16_t* p = dst + (size_t)row * ld + col + 32 * wc + 4 * fq; gst8(p, w0.x, w0.y); gst8(p + 16, w1.x, w1.y);
                }
        }
        if (kind == 2) {
            float* S = (u.rn == 0) ? SSKV : SSQ;
#pragma unroll
            for (int ai = 0; ai < 2; ++ai)
#pragma unroll
                for (int m = 0; m < 4; ++m) {
                    float s = ss[ai][m]; s += __shfl_xor(s, 16); s += __shfl_xor(s, 32);
                    if (fq == 0) *(PG8_GAS float*)(S + (size_t)(row0 + ai * HALF + m * 16) * 4 + wc) = s;
                }
        }
    }
};

struct EpiP2 {
    static constexpr bool PERM = true, AFTER_DRAIN = false;
    bf16_t *MK, *MV, *QN, *QR; const float *SSKV, *SSQ; const float* TAB; float qscale; float eps;
    __device__ __forceinline__ void operator()(const f32x4 (&acc)[2][2][4][2], const Unit& u, int wr, int wc, int fr, int fq) const {
        const bool isq = (u.aux & 0x100) != 0, lat = u.rm < 64;
        const int row0 = u.rm * BM + wr * 64 + fr;
        const float* SS = isq ? SSQ : SSKV;
#pragma unroll
        for (int ai = 0; ai < 2; ++ai)
#pragma unroll
            for (int m = 0; m < 4; ++m) {
                const int row = row0 + ai * HALF + m * 16;
                const f32x4 s4 = gldf4(SS + (size_t)row * 4);
                float rs = rsqrtf(((s4[0] + s4[1]) + (s4[2] + s4[3])) * (1.0f / 256.0f) + eps);
                if (isq) rs *= qscale;
#pragma unroll
                for (int bj = 0; bj < 2; ++bj) {
                    f32x4 x0 = acc[ai][bj][m][0] * rs, x1 = acc[ai][bj][m][1] * rs;
                    bf16_t* p;
                    if (!isq) {
                        const int head = 2 * u.rn + bj;
                        p = ((wc < 2) ? MK : MV) + (size_t)row * 512 + head * 64 + (wc & 1) * 32 + 8 * fq;
                    } else {
                        const int g = u.rn * 8 + bj * 4 + wc, head = g / 3, part = g - head * 3;
                        if (part < 2) p = QN + (size_t)row * 512 + head * 64 + part * 32 + 8 * fq;
                        else {
                            p = QR + (size_t)row * 256 + head * 32 + 8 * fq;
                            if (lat) {
                                f32x4 o0, o1;
#pragma unroll
                                for (int j = 0; j < 4; ++j) { o0[j] = __shfl_xor(x0[j], 16); o1[j] = __shfl_xor(x1[j], 16); }
                                const int pos = (fq & 2) ? (row & 63) : ((row >> 6) & 63);
                                const f32x4 c0 = gldf4(TAB + 2048 + pos * 8), c1 = gldf4(TAB + 2048 + pos * 8 + 4);
                                const f32x4 s0 = gldf4(TAB + 2560 + pos * 8), s1 = gldf4(TAB + 2560 + pos * 8 + 4);
                                if ((fq & 1) == 0) { x0 = x0 * c0 - o0 * s0; x1 = x1 * c1 - o1 * s1; } else { x0 = x0 * c0 + o0 * s0; x1 = x1 * c1 + o1 * s1; }
                            }
                        }
                    }
                    u32x4 w; w.x = cvt_pk_bf16(x0[0], x0[1]); w.y = cvt_pk_bf16(x0[2], x0[3]); w.z = cvt_pk_bf16(x1[0], x1[1]); w.w = cvt_pk_bf16(x1[2], x1[3]);
                    gst16(p, w);
                }
            }
    }
};

#ifndef MK_SIG_PERM
#define MK_SIG_PERM true
#endif
struct EpiSig {
    static constexpr bool PERM = MK_SIG_PERM, AFTER_DRAIN = false;
    bf16_t* G;
    __device__ __forceinline__ void operator()(const f32x4 (&acc)[2][2][4][2], const Unit& u, int wr, int wc, int fr, int fq) const {
        const int row0 = u.rm * BM + wr * 64 + fr;
#pragma unroll
        for (int ai = 0; ai < 2; ++ai)
#pragma unroll
            for (int m = 0; m < 4; ++m)
#pragma unroll
                for (int bj = 0; bj < 2; ++bj) {
                    const f32x4 x0 = acc[ai][bj][m][0], x1 = acc[ai][bj][m][1];
                    u32x4 w; w.x = cvt_pk_bf16(fast_sigmoid(x0[0]), fast_sigmoid(x0[1])); w.y = cvt_pk_bf16(fast_sigmoid(x0[2]), fast_sigmoid(x0[3]));
                    w.z = cvt_pk_bf16(fast_sigmoid(x1[0]), fast_sigmoid(x1[1])); w.w = cvt_pk_bf16(fast_sigmoid(x1[2]), fast_sigmoid(x1[3]));
                    bf16_t* rowp = G + (size_t)(row0 + ai * HALF + m * 16) * 3072 + u.rn * BM + bj * HALF + wc * 32;
#ifdef MK_SIG_ST8
                    if (PERM) { gst8(rowp + 8 * fq, w.x, w.y); gst8(rowp + 8 * fq + 4, w.z, w.w); }
#else
                    if (PERM) gst16(rowp + 8 * fq, w);
#endif
                    else { gst8(rowp + 4 * fq, w.x, w.y); gst8(rowp + 16 + 4 * fq, w.z, w.w); }
                }
    }
};

struct EpiMerge {
    static constexpr bool PERM = true, AFTER_DRAIN = false;
    const bf16_t* G; bf16_t* Mb;
    __device__ __forceinline__ void operator()(const f32x4 (&acc)[2][2][4][2], const Unit& u, int wr, int wc, int fr, int fq) const {
        const int br = u.aux & 0xff;
        const int row0 = u.rm * BM + wr * 64 + fr, col0 = u.rn * BM + wc * 32 + 8 * fq;
#pragma unroll
        for (int ai = 0; ai < 2; ++ai) {
            u32x4 g[4][2], mo[4][2];
#pragma unroll
            for (int m = 0; m < 4; ++m)
#pragma unroll
                for (int bj = 0; bj < 2; ++bj) {
                    const size_t row = (size_t)(row0 + ai * HALF + m * 16); const int col = col0 + bj * HALF;
                    g[m][bj] = gld16(G + row * 3072 + br * 1024 + col);
                    mo[m][bj] = (u32x4){0u, 0u, 0u, 0u}; if (br != 0) mo[m][bj] = gld16(Mb + row * 1024 + col);
                }
#pragma unroll
            for (int m = 0; m < 4; ++m)
#pragma unroll
                for (int bj = 0; bj < 2; ++bj) {
                    const size_t row = (size_t)(row0 + ai * HALF + m * 16); const int col = col0 + bj * HALF;
                    const f32x4 x0 = acc[ai][bj][m][0], x1 = acc[ai][bj][m][1]; const u32x4 gg = g[m][bj], mm = mo[m][bj];
                    u32x4 w;
                    w.x = cvt_pk_bf16(bf_lo(mm.x) + bf_lo(gg.x) * x0[0], bf_hi(mm.x) + bf_hi(gg.x) * x0[1]);
                    w.y = cvt_pk_bf16(bf_lo(mm.y) + bf_lo(gg.y) * x0[2], bf_hi(mm.y) + bf_hi(gg.y) * x0[3]);
                    w.z = cvt_pk_bf16(bf_lo(mm.z) + bf_lo(gg.z) * x1[0], bf_hi(mm.z) + bf_hi(gg.z) * x1[1]);
                    w.w = cvt_pk_bf16(bf_lo(mm.w) + bf_lo(gg.w) * x1[2], bf_hi(mm.w) + bf_hi(gg.w) * x1[3]);
                    gst16(Mb + row * 1024 + col, w);
                }
        }
    }
};

struct EpiF32 {
    static constexpr bool PERM = false, AFTER_DRAIN = false;
    float* Y; int ldc;
    __device__ __forceinline__ void operator()(const f32x4 (&acc)[2][2][4][2], const Unit& u, int wr, int wc, int fr, int fq) const {
        const int row0 = u.rm * BM + wr * 64 + fr, col0 = u.rn * BM + wc * 32 + 4 * fq;
#pragma unroll
        for (int ai = 0; ai < 2; ++ai)
#pragma unroll
            for (int m = 0; m < 4; ++m)
#pragma unroll
                for (int bj = 0; bj < 2; ++bj)
#pragma unroll
                    for (int n = 0; n < 2; ++n) gstf4(Y + (size_t)(row0 + ai * HALF + m * 16) * ldc + col0 + bj * HALF + n * 16, acc[ai][bj][m][n]);
    }
};

struct EpiSwiglu {
    static constexpr bool PERM = true, AFTER_DRAIN = false;
    bf16_t* ACT;
    __device__ __forceinline__ void operator()(const f32x4 (&acc)[2][2][4][2], const Unit& u, int wr, int wc, int fr, int fq) const {
        const int row0 = u.rm * BM + wr * 64 + fr, col0 = u.rn * HALF + wc * 32 + 8 * fq;
#pragma unroll
        for (int ai = 0; ai < 2; ++ai)
#pragma unroll
            for (int m = 0; m < 4; ++m) {
                const f32x4 g0 = acc[ai][0][m][0], g1 = acc[ai][0][m][1], u0 = acc[ai][1][m][0], u1 = acc[ai][1][m][1];
                u32x4 w;
                w.x = cvt_pk_bf16(g0[0] * fast_sigmoid(g0[0]) * u0[0], g0[1] * fast_sigmoid(g0[1]) * u0[1]);
                w.y = cvt_pk_bf16(g0[2] * fast_sigmoid(g0[2]) * u0[2], g0[3] * fast_sigmoid(g0[3]) * u0[3]);
                w.z = cvt_pk_bf16(g1[0] * fast_sigmoid(g1[0]) * u1[0], g1[1] * fast_sigmoid(g1[1]) * u1[1]);
                w.w = cvt_pk_bf16(g1[2] * fast_sigmoid(g1[2]) * u1[2], g1[3] * fast_sigmoid(g1[3]) * u1[3]);
                gst16(ACT + (size_t)(row0 + ai * HALF + m * 16) * 2816 + col0, w);
            }
    }
};

template <class Epi, class Sched, bool ALIGN_EPI = false, bool SP2 = false>
__device__ __forceinline__ void gemm_phase(PG8_LAS unsigned char* lds, const Gemm g, const Sched& S, const Epi& E, const int wave_in, const int lane_in) {
    const int wid = wave_in, lane = lane_in, tid = wid * 64 + lane, wr = wid >> 2, wc = wid & 3, fr = lane & 15, fq = lane >> 4;
    const int K = g.K, nt = K / BK;
    unsigned voffA[2], voffB[2];
#pragma unroll
    for (int i = 0; i < 2; ++i) { int R, C; stage_rc(tid * 16 + i * 8192, R, C); const int Rb = Epi::PERM ? ((R & ~31) + perm32(R & 31)) : R;
        voffA[i] = (unsigned)(R * K + C) * 2u; voffB[i] = (unsigned)(Rb * K + C) * 2u; }
    const size_t kstep = (size_t)(BK * 2);
    const size_t hstep = (size_t)HALF * K * 2;
    const size_t tstep = 2 * hstep;
    const unsigned ldsw = (unsigned)wid * 1024u;
    const int aoff = lds_byte(wr * 64 + fr, fq * 8), boff = lds_byte(wc * 32 + fr, fq * 8);
#define PG8_SA(b, h) (((b) * 2 + (h)) * HTB)
#define PG8_SB(b, h) ((4 + (b) * 2 + (h)) * HTB)
#define PG8_STAGE(bufoff, gbase, voff) do { _Pragma("unroll") for (int _i = 0; _i < 2; ++_i) \
        __builtin_amdgcn_global_load_lds((const unsigned*)((const char*)(gbase) + (voff)[_i]), (PG8_LAS unsigned*)(lds + (bufoff) + ldsw + _i * 8192), 16, 0, 0); } while (0)
#define PG8_LDA(dst, b, h) do { _Pragma("unroll") for (int m = 0; m < 4; ++m) _Pragma("unroll") for (int k = 0; k < 2; ++k) dst[m][k] = *(const PG8_LAS bf16x8*)(lds + PG8_SA(b, h) + aoff + m * 2048 + k * 1024); } while (0)
#define PG8_LDB(dst, b, h) do { _Pragma("unroll") for (int n = 0; n < 2; ++n) _Pragma("unroll") for (int k = 0; k < 2; ++k) dst[n][k] = *(const PG8_LAS bf16x8*)(lds + PG8_SB(b, h) + boff + n * 2048 + k * 1024); } while (0)
#define PG8_MMA(ai, bj, At, Bt) do { __builtin_amdgcn_s_setprio(1); _Pragma("unroll") for (int m = 0; m < 4; ++m) _Pragma("unroll") for (int n = 0; n < 2; ++n) _Pragma("unroll") for (int k = 0; k < 2; ++k) \
        acc[ai][bj][m][n] = __builtin_amdgcn_mfma_f32_16x16x32_bf16(Bt[n][k], At[m][k], acc[ai][bj][m][n], 0, 0, 0); __builtin_amdgcn_s_setprio(0); } while (0)
#define PG8_WAIT_V(n) asm volatile("s_waitcnt vmcnt(" #n ")" ::: "memory")
#define PG8_WAIT_L(n) asm volatile("s_waitcnt lgkmcnt(" #n ")" ::: "memory")
#define PG8_BAR __builtin_amdgcn_s_barrier()
#define PG8_SCHED __builtin_amdgcn_sched_barrier(0)
    Unit cur, nxt; int ui = 0;
    if (!S.next(0, cur)) return;
    f32x4 acc[2][2][4][2];
#pragma unroll
    for (int a = 0; a < 2; ++a)
#pragma unroll
        for (int b = 0; b < 2; ++b)
#pragma unroll
            for (int m = 0; m < 4; ++m)
#pragma unroll
                for (int n = 0; n < 2; ++n) acc[a][b][m][n] = (f32x4){0.f, 0.f, 0.f, 0.f};
    bf16x8 At[4][2], B0[2][2], B1[2][2];
    const char* cA = (const char*)g.A + (size_t)cur.pm * tstep; const char* cB = (const char*)g.Bt + (size_t)cur.pn * tstep;
    S.a_ready(cur);
    if constexpr (SP2) {
        PG8_STAGE(PG8_SB(0, 0), cB, voffB); PG8_STAGE(PG8_SB(0, 1), cB + hstep, voffB); PG8_STAGE(PG8_SA(0, 0), cA, voffA); PG8_STAGE(PG8_SA(0, 1), cA + hstep, voffA);
        if (wr == 1) PG8_BAR;
        PG8_WAIT_V(2); PG8_BAR;
        PG8_STAGE(PG8_SB(1, 0), cB + kstep, voffB); PG8_STAGE(PG8_SA(1, 0), cA + kstep, voffA); PG8_STAGE(PG8_SB(1, 1), cB + hstep + kstep, voffB);
        PG8_WAIT_V(6); PG8_BAR;
    } else {
        PG8_STAGE(PG8_SB(0, 0), cB, voffB); PG8_STAGE(PG8_SA(0, 0), cA, voffA); PG8_STAGE(PG8_SB(0, 1), cB + hstep, voffB); PG8_STAGE(PG8_SA(0, 1), cA + hstep, voffA);
        if (wr == 1) PG8_BAR;
        PG8_WAIT_V(4); PG8_BAR;
        PG8_STAGE(PG8_SB(1, 0), cB + kstep, voffB); PG8_STAGE(PG8_SA(1, 0), cA + kstep, voffA); PG8_STAGE(PG8_SB(1, 1), cB + hstep + kstep, voffB);
        PG8_WAIT_V(6); PG8_BAR;
    }
    for (;;) {
        const bool has_next = S.next(ui + 1, nxt);
        const char* nA = has_next ? (const char*)g.A + (size_t)nxt.pm * tstep : cA; const char* nB = has_next ? (const char*)g.Bt + (size_t)nxt.pn * tstep : cB;
        for (int t = 0; t < nt; t += 2) {
            const bool last = (t == nt - 2);
            const char* a1 = cA + (size_t)(t + 1) * kstep;
            const char* a2 = last ? nA : cA + (size_t)(t + 2) * kstep; const char* b2 = last ? nB : cB + (size_t)(t + 2) * kstep;
            const char* a3 = a2 + kstep; const char* b3 = b2 + kstep;
            if (last && has_next) S.a_ready(nxt);
            if constexpr (SP2) {
            PG8_LDB(B0, 0, 0); PG8_LDB(B1, 0, 1); PG8_SCHED; PG8_LDA(At, 0, 0); PG8_STAGE(PG8_SA(1, 1), a1 + hstep, voffA);
            PG8_WAIT_V(8); PG8_WAIT_L(0); PG8_BAR; PG8_MMA(0, 0, At, B0); PG8_MMA(0, 1, At, B1); PG8_BAR; PG8_SCHED;
            PG8_LDA(At, 0, 1); PG8_STAGE(PG8_SB(0, 0), b2, voffB); PG8_STAGE(PG8_SB(0, 1), b2 + hstep, voffB); PG8_STAGE(PG8_SA(0, 0), a2, voffA);
            PG8_WAIT_V(8); PG8_WAIT_L(0); PG8_BAR; PG8_MMA(1, 0, At, B0); PG8_MMA(1, 1, At, B1); PG8_BAR; PG8_SCHED;
            PG8_LDB(B0, 1, 0); PG8_LDB(B1, 1, 1); PG8_SCHED; PG8_LDA(At, 1, 0); PG8_STAGE(PG8_SA(0, 1), a2 + hstep, voffA);
            PG8_WAIT_V(8); PG8_WAIT_L(0); PG8_BAR; PG8_MMA(0, 0, At, B0); PG8_MMA(0, 1, At, B1); PG8_BAR; PG8_SCHED;
            PG8_LDA(At, 1, 1); PG8_STAGE(PG8_SB(1, 0), b3, voffB); PG8_STAGE(PG8_SB(1, 1), b3 + hstep, voffB); PG8_STAGE(PG8_SA(1, 0), a3, voffA);
            PG8_WAIT_V(8); PG8_WAIT_L(0); PG8_BAR; PG8_MMA(1, 0, At, B0); PG8_MMA(1, 1, At, B1); PG8_BAR; PG8_SCHED;
            } else {
            PG8_LDB(B0, 0, 0); PG8_SCHED; PG8_LDA(At, 0, 0); PG8_STAGE(PG8_SA(1, 1), a1 + hstep, voffA);
            PG8_WAIT_L(8); PG8_BAR; PG8_WAIT_L(0); PG8_MMA(0, 0, At, B0); PG8_BAR; PG8_SCHED;
            PG8_LDB(B1, 0, 1); PG8_STAGE(PG8_SB(0, 0), b2, voffB);
            PG8_BAR; PG8_WAIT_L(0); PG8_MMA(0, 1, At, B1); PG8_BAR;
            PG8_LDA(At, 0, 1); PG8_STAGE(PG8_SA(0, 0), a2, voffA);
            PG8_BAR; PG8_WAIT_L(0); PG8_MMA(1, 0, At, B0); PG8_BAR; PG8_SCHED;
            PG8_STAGE(PG8_SB(0, 1), b2 + hstep, voffB);
            PG8_WAIT_V(6); PG8_BAR; PG8_MMA(1, 1, At, B1); PG8_BAR;
            PG8_LDB(B0, 1, 0); PG8_SCHED; PG8_LDA(At, 1, 0); PG8_STAGE(PG8_SA(0, 1), a2 + hstep, voffA);
            PG8_WAIT_L(8); PG8_BAR; PG8_WAIT_L(0); PG8_MMA(0, 0, At, B0); PG8_BAR; PG8_SCHED;
            PG8_LDB(B1, 1, 1); PG8_STAGE(PG8_SB(1, 0), b3, voffB);
            PG8_BAR; PG8_WAIT_L(0); PG8_MMA(0, 1, At, B1); PG8_BAR;
            PG8_LDA(At, 1, 1); PG8_STAGE(PG8_SA(1, 0), a3, voffA);
            PG8_BAR; PG8_WAIT_L(0); PG8_MMA(1, 0, At, B0); PG8_BAR; PG8_SCHED;
            PG8_STAGE(PG8_SB(1, 1), b3 + hstep, voffB);
            PG8_WAIT_V(6); PG8_BAR; PG8_MMA(1, 1, At, B1); PG8_BAR;
            }
        }
        if constexpr (ALIGN_EPI) { if (wr == 0) PG8_BAR; }
        if constexpr (!Epi::AFTER_DRAIN) {
            int ln_; asm volatile("v_mbcnt_lo_u32_b32 %0, -1, 0\n\tv_mbcnt_hi_u32_b32 %0, -1, %0" : "=v"(ln_));
            E(acc, cur, wr, wc, ln_ & 15, ln_ >> 4); S.done(cur); }
        if (!has_next) break;
#pragma unroll
        for (int a = 0; a < 2; ++a)
#pragma unroll
            for (int b = 0; b < 2; ++b)
#pragma unroll
                for (int m = 0; m < 4; ++m)
#pragma unroll
                    for (int n = 0; n < 2; ++n) acc[a][b][m][n] = (f32x4){0.f, 0.f, 0.f, 0.f};
        cur = nxt; cA = nA; cB = nB; ++ui;
        if constexpr (ALIGN_EPI) { if (wr == 1) PG8_BAR; }
    }
    PG8_WAIT_V(0);
    if constexpr (!ALIGN_EPI) { if (wr == 0) PG8_BAR; }
    PG8_BAR;
    if constexpr (Epi::AFTER_DRAIN) { E.fused(acc, cur, wr, wc, fr, fq, lds, wid, lane); S.done(cur); }
#undef PG8_SA
#undef PG8_SB
#undef PG8_STAGE
#undef PG8_LDA
#undef PG8_LDB
#undef PG8_MMA
#undef PG8_WAIT_V
#undef PG8_WAIT_L
#undef PG8_BAR
#undef PG8_SCHED
}
}

namespace att {
#define ALAS __attribute__((address_space(3)))
#define AGAS __attribute__((address_space(1)))
typedef unsigned short bf16_t;
typedef short bf16x8 __attribute__((ext_vector_type(8)));
typedef short s16x4 __attribute__((ext_vector_type(4)));
typedef float f32x16 __attribute__((ext_vector_type(16)));
typedef unsigned u32x4 __attribute__((ext_vector_type(4)));
#ifndef ATT_STAGGER
#define ATT_STAGGER 1
#endif
#ifndef ATT_NEGM
#define ATT_NEGM 1
#endif
constexpr int SLOT = 24576, NSLOT = 4, WSF_OFF = NSLOT * SLOT, LDS_NEED = WSF_OFF + 2048;
constexpr float THR = 6.0f;
__device__ __forceinline__ int crow(int r, int hi) { return (r & 3) + 8 * (r >> 2) + 4 * hi; }
typedef float f32x2_t __attribute__((ext_vector_type(2))); typedef __bf16 bf16x2_t __attribute__((ext_vector_type(2)));
__device__ __forceinline__ unsigned cvtpk(float lo, float hi) { f32x2_t v = {lo, hi}; bf16x2_t b = __builtin_convertvector(v, bf16x2_t); return __builtin_bit_cast(unsigned, b); }
__device__ __forceinline__ s16x4 vtr(const ALAS unsigned char* p) { typedef short v4i16_t __attribute__((ext_vector_type(4))); return __builtin_bit_cast(s16x4, __builtin_amdgcn_ds_read_tr16_b64_v4i16((ALAS v4i16_t*)p)); }

__device__ __forceinline__ void glds16(const void* gsrc, unsigned lds_dst) { unsigned keep;
    asm volatile("s_mov_b32 %0, m0\n\ts_mov_b32 m0, %2\n\ts_nop 0\n\tglobal_load_lds_dwordx4 %1, off\n\ts_mov_b32 m0, %0" : "=&s"(keep) : "v"(gsrc), "s"(lds_dst) : "memory"); }
#define ATT_WAIT_BAR(N) asm volatile("s_waitcnt vmcnt(" #N ") lgkmcnt(0)\n\ts_barrier" ::: "memory")

struct Src {
    const bf16_t* k1; int ldk1;
    const bf16_t* k2; int ldk2;
    const bf16_t* v;  int ldv;
    int ctx_row0;
    int lat_row0, nlat;
};

template <int DQK, int DV, int MODE>
__device__ __forceinline__ void attn_pass(ALAS unsigned char* lds, const Src& S, const bf16_t* qp, int ldq, const bf16_t* qp2, int ldq2, float sink2, int tq0  , int slat0  , f32x16 (&o)[DV / 32], int wid, int lane) {
    constexpr int NKS = DQK / 16, NDB = DV / 32, NKP = DQK / 8, NVP = NDB * 4;
    constexpr bool NEGM = ATT_NEGM && (DV < 128);
    const int r32 = lane & 31, hi = lane >> 5;
    const bool late = ATT_STAGGER && (wid >= 4);
    ALAS float* wsf = (ALAS float*)(lds + WSF_OFF) + wid * 64;
    const int NT = 4 + S.nlat;
    bf16x8 qf[NKS];
#pragma unroll
    for (int d0 = 0; d0 < NKS; ++d0) {
        if (d0 < 4) qf[d0] = *(const AGAS bf16x8*)(qp + (size_t)(wid * 32 + r32) * ldq + d0 * 16 + hi * 8);
        else qf[d0] = *(const AGAS bf16x8*)(qp2 + (size_t)(wid * 32 + r32) * ldq2 + (d0 - 4) * 16 + hi * 8);
    }
    constexpr int KB = DQK * 128, NKI = (NKP + 7) / 8, NVI = NVP / 8, NPER = NKI + NVI;
    const unsigned lds0 = (unsigned)(uintptr_t)lds;
    auto issue = [&](int t) {
        const int krow = (t < 4) ? (S.ctx_row0 + 64 * t) : (S.lat_row0 + 64 * (t - 4));
        const unsigned sb = lds0 + (unsigned)((t % NSLOT) * SLOT);
#pragma unroll
        for (int i = 0; i < NKI; ++i) {
            int c = wid + 8 * i; if (c >= NKP) c = wid;
            const bf16_t* src = (c < 8) ? (S.k1 + (size_t)(krow + lane) * S.ldk1 + c * 8) : (S.k2 + (size_t)(krow + lane) * S.ldk2 + (c - 8) * 8);
            glds16(src, (unsigned)__builtin_amdgcn_readfirstlane(sb + c * 1024));
        }
#pragma unroll
        for (int i = 0; i < NVI; ++i) {
            const int p = wid + 8 * i, db = p >> 2, ks = p & 3;
            const bf16_t* src = S.v + (size_t)(krow + 16 * ks + (lane >> 2)) * S.ldv + db * 32 + (lane & 3) * 8;
            glds16(src, (unsigned)__builtin_amdgcn_readfirstlane(sb + KB + p * 1024));
        }
    };
    float mrun = (MODE == 1) ? sink2 : 0.0f;
    float lrun = (MODE == 1 && hi == 0) ? 1.0f : 0.0f;
#pragma unroll
    for (int db = 0; db < NDB; ++db)
#pragma unroll
        for (int r = 0; r < 16; ++r) o[db][r] = 0.f;
    f32x16 negm;
    if constexpr (NEGM) {
#pragma unroll
        for (int r = 0; r < 16; ++r) negm[r] = -mrun;
    }
    const int tw0 = tq0 + wid * 32;
    const int vp = ((lane >> 4) & 1) * 32 + (lane & 3) * 8 + (4 * hi + ((lane & 15) >> 2)) * 64;
    auto pv = [&](const u32x4 (&pwv)[4], const ALAS unsigned char* sbv) {
        constexpr int NF = NDB * 4, PDV = 3;
        const ALAS unsigned char* vb = sbv + KB + vp;
        s16x4 vlo[PDV], vhi[PDV];
#pragma unroll
        for (int i = 0; i < PDV; ++i) { vlo[i] = vtr(vb + i * 1024); vhi[i] = vtr(vb + i * 1024 + 512); }
        __builtin_amdgcn_sched_barrier(0);
#pragma unroll
        for (int i = 0; i < NF; ++i) {
            const s16x4 lo = vlo[i % PDV], hh = vhi[i % PDV];
            if (i + PDV < NF) { vlo[i % PDV] = vtr(vb + (i + PDV) * 1024); vhi[i % PDV] = vtr(vb + (i + PDV) * 1024 + 512); }
            const bf16x8 vf = (bf16x8){lo[0], lo[1], lo[2], lo[3], hh[0], hh[1], hh[2], hh[3]};
            o[i >> 2] = __builtin_amdgcn_mfma_f32_32x32x16_bf16(__builtin_bit_cast(bf16x8, pwv[i & 3]), vf, o[i >> 2], 0, 0, 0);
            __builtin_amdgcn_sched_barrier(0);
        }
    };
    u32x4 pw[4];
    const ALAS unsigned char* sb_pend = lds; bool pend = false;
    issue(0); issue(1);
    int slot = 0;
    for (int t = 0; t < NT; ++t) {
        if (t + 1 < NT) { if constexpr (NPER == 2) ATT_WAIT_BAR(2); else ATT_WAIT_BAR(3); } else ATT_WAIT_BAR(0);
        if (t + 2 < NT) issue(t + 2);
        const ALAS unsigned char* sb = lds + slot * SLOT;
        slot = (slot == NSLOT - 1) ? 0 : slot + 1;
        if (pend) { pv(pw, sb_pend); pend = false; }
        bool partial = false, active = true;
        if (MODE == 1 && t >= 4) {
            const int sb0 = slat0 + 64 * (t - 4);
            active = !(sb0 > tw0 + 31 + 128 || sb0 + 63 < tw0 - 128);
            partial = (tw0 + 31 - sb0 > 128) || (sb0 + 63 - tw0 > 128);
        }
        if (!active) continue;
        f32x16 p0, p1;
        if constexpr (NEGM) { p0 = negm; p1 = negm; }
        else {
#pragma unroll
            for (int r = 0; r < 16; ++r) { p0[r] = 0.f; p1[r] = 0.f; }
        }
        {
            constexpr int NF = 2 * NKS, PDK = 4;
            const ALAS unsigned char* kb = sb + hi * 1024 + r32 * 16;
            bf16x8 kbuf[PDK];
#pragma unroll
            for (int i = 0; i < PDK; ++i) kbuf[i] = *(const ALAS bf16x8*)(kb + (i >> 1) * 2048 + (i & 1) * 512);
            __builtin_amdgcn_sched_barrier(0);
#pragma unroll
            for (int i = 0; i < NF; ++i) {
                const bf16x8 kf = kbuf[i % PDK];
                if (i + PDK < NF) kbuf[i % PDK] = *(const ALAS bf16x8*)(kb + ((i + PDK) >> 1) * 2048 + ((i + PDK) & 1) * 512);
                if (i & 1) p1 = __builtin_amdgcn_mfma_f32_32x32x16_bf16(kf, qf[i >> 1], p1, 0, 0, 0);
                else p0 = __builtin_amdgcn_mfma_f32_32x32x16_bf16(kf, qf[i >> 1], p0, 0, 0, 0);
                __builtin_amdgcn_sched_barrier(0);
            }
        }
        if (MODE == 1 && partial) {
            const int sb0 = slat0 + 64 * (t - 4), tq = tw0 + r32;
#pragma unroll
            for (int r = 0; r < 16; ++r) {
                const int s0 = sb0 + crow(r, hi), d0 = tq - s0, d1 = d0 - 32;
                if (d0 > 128 || d0 < -128) p0[r] = -INFINITY;
                if (d1 > 128 || d1 < -128) p1[r] = -INFINITY;
            }
        }
        float rm = fmaxf(p0[0], p1[0]);
#pragma unroll
        for (int r = 1; r < 16; ++r) rm = fmaxf(rm, fmaxf(p0[r], p1[r]));
        { auto rr = __builtin_amdgcn_permlane32_swap(__float_as_uint(rm), __float_as_uint(rm), false, false); rm = fmaxf(__uint_as_float(rr[0]), __uint_as_float(rr[1])); }
        if constexpr (!NEGM) rm -= mrun;
        if (__any(rm > THR)) {
            const float dl = fmaxf(rm, 0.f), al = __builtin_amdgcn_exp2f(-dl);
            mrun += dl; lrun *= al;
            if constexpr (NEGM) {
#pragma unroll
                for (int r = 0; r < 16; ++r) { p0[r] -= dl; p1[r] -= dl; negm[r] = -mrun; }
            }
            if (hi == 0) wsf[r32] = al;
#pragma unroll
            for (int r = 0; r < 16; ++r) { const float a = wsf[crow(r, hi)];
#pragma unroll
                for (int db = 0; db < NDB; ++db) o[db][r] *= a; }
        }
        __builtin_amdgcn_sched_barrier(0);
        float sum = 0.f;
#pragma unroll
        for (int r = 0; r < 16; ++r) {
            if constexpr (NEGM) { p0[r] = __builtin_amdgcn_exp2f(p0[r]); p1[r] = __builtin_amdgcn_exp2f(p1[r]); }
            else { p0[r] = __builtin_amdgcn_exp2f(p0[r] - mrun); p1[r] = __builtin_amdgcn_exp2f(p1[r] - mrun); }
            sum += p0[r] + p1[r]; }
        lrun += sum;
#pragma unroll
        for (int w = 0; w < 4; ++w) { pw[0][w] = cvtpk(p0[2 * w], p0[2 * w + 1]); pw[1][w] = cvtpk(p0[8 + 2 * w], p0[8 + 2 * w + 1]); pw[2][w] = cvtpk(p1[2 * w], p1[2 * w + 1]); pw[3][w] = cvtpk(p1[8 + 2 * w], p1[8 + 2 * w + 1]); }
        __builtin_amdgcn_sched_barrier(0);
        if (late) { pend = true; sb_pend = sb; } else pv(pw, sb);
    }
    if (pend) pv(pw, sb_pend);
    { auto rr = __builtin_amdgcn_permlane32_swap(__float_as_uint(lrun), __float_as_uint(lrun), false, false); lrun = __uint_as_float(rr[0]) + __uint_as_float(rr[1]); }
    if (hi == 0) wsf[32 + r32] = lrun;
    ATT_WAIT_BAR(0);
}

template <int DV>
__device__ __forceinline__ void store_o(ALAS unsigned char* lds, const f32x16 (&o)[DV / 32], bf16_t* dst  , int ldo, int wid, int lane) {
    asm volatile("" : "+v"(lane));
    const int r32 = lane & 31, hi = lane >> 5;
    ALAS bf16_t* stg = (ALAS bf16_t*)(lds + wid * 8192);
#pragma unroll
    for (int r = 0; r < 16; ++r) { const int orow = crow(r, hi);
#pragma unroll
        for (int db = 0; db < DV / 32; ++db) { const unsigned w = cvtpk(o[db][r], 0.f); stg[orow * DV + db * 32 + r32] = (bf16_t)(w & 0xffffu); } }
    constexpr int CH = DV / 8, RPI = 64 / CH;
#pragma unroll
    for (int i = 0; i < 32 / RPI; ++i) { const int row = i * RPI + lane / CH, ch = lane % CH;
        const u32x4 v = *(const ALAS u32x4*)(stg + row * DV + ch * 8); *(AGAS u32x4*)(dst + (size_t)row * ldo + ch * 8) = v; }
}

struct Bufs {
    bf16_t *QN, *QR, *MK, *MV, *KR, *DQ, *DK, *DV_, *SQ, *SK, *SV;
    bf16_t *OA, *OB, *OC; int dry;
    const float* lam; const float* dnorm; const float* sink; float lam_init; float eps;
};
__device__ __forceinline__ void attn_unit(ALAS unsigned char* lds, const Bufs& B, int type, int b, int h, int qb, int wid, int lane) {
    asm volatile("" : "+v"(lane));
    const bool ctxq = (qb == 16);
    const int qrow0 = ctxq ? (16384 + b * 256) : (b * 4096 + qb * 256);
    const int tq0 = qb * 256;
    Src S; S.ctx_row0 = 16384 + b * 256; S.k2 = nullptr; S.ldk2 = 0;
    const int r32 = lane & 31, hi = lane >> 5;
    ALAS float* wsf = (ALAS float*)(lds + WSF_OFF) + wid * 64;
    if (type == 0) {
        S.k1 = B.MK + h * 64; S.ldk1 = 512; S.k2 = B.KR; S.ldk2 = 32; S.v = B.MV + h * 64; S.ldv = 512;
        S.lat_row0 = b * 4096; S.nlat = ctxq ? 0 : 64;
        f32x16 o[2];
        attn_pass<96, 64, 0>(lds, S, B.QN + (size_t)qrow0 * 512 + h * 64, 512, B.QR + (size_t)qrow0 * 256 + h * 32, 256, 0.f, tq0, 0, o, wid, lane);
#pragma unroll
        for (int r = 0; r < 16; ++r) { const float il = __builtin_amdgcn_rcpf(wsf[32 + crow(r, hi)]); o[0][r] *= il; o[1][r] *= il; }
        if (!B.dry) store_o<64>(lds, o, B.OA + (size_t)(qrow0 + wid * 32) * 512 + h * 64, 512, wid, lane);
    } else if (type == 2) {
        const int hk = h >> 2;
        S.k1 = B.SK + hk * 64; S.ldk1 = 128; S.v = B.SV + hk * 64; S.ldv = 128;
        int lo = tq0 - 128; if (lo < 0) lo = 0; int hi_ = tq0 + 256 + 128; if (hi_ > 4096) hi_ = 4096;
        S.lat_row0 = b * 4096 + lo; S.nlat = ctxq ? 0 : (hi_ - lo) / 64;
        f32x16 o[2];
        attn_pass<64, 64, 1>(lds, S, B.SQ + (size_t)qrow0 * 512 + h * 64, 512, nullptr, 0, *(const AGAS float*)(B.sink + h) * 1.4426950408889634f, tq0, lo, o, wid, lane);
#pragma unroll
        for (int r = 0; r < 16; ++r) { const float il = __builtin_amdgcn_rcpf(wsf[32 + crow(r, hi)]); o[0][r] *= il; o[1][r] *= il; }
        if (!B.dry) store_o<64>(lds, o, B.OC + (size_t)(qrow0 + wid * 32) * 512 + h * 64, 512, wid, lane);
    } else {
        S.v = B.DV_ + h * 128; S.ldv = 512; S.lat_row0 = b * 4096; S.nlat = ctxq ? 0 : 64; S.ldk1 = 512;
        f32x16 o1[4]; unsigned o0p[4][8];
        S.k1 = B.DK + (2 * h) * 64;
        attn_pass<64, 128, 0>(lds, S, B.DQ + (size_t)qrow0 * 512 + (2 * h) * 64, 512, nullptr, 0, 0.f, tq0, 0, o1, wid, lane);
#pragma unroll
        for (int r = 0; r < 16; r += 2) { const float il0 = __builtin_amdgcn_rcpf(wsf[32 + crow(r, hi)]), il1 = __builtin_amdgcn_rcpf(wsf[32 + crow(r + 1, hi)]);
#pragma unroll
            for (int db = 0; db < 4; ++db) o0p[db][r >> 1] = cvtpk(o1[db][r] * il0, o1[db][r + 1] * il1); }
        S.k1 = B.DK + (2 * h + 1) * 64;
        attn_pass<64, 128, 0>(lds, S, B.DQ + (size_t)qrow0 * 512 + (2 * h + 1) * 64, 512, nullptr, 0, 0.f, tq0, 0, o1, wid, lane);
        int r32b = r32; asm volatile("" : "+v"(r32b));
        const float lam = *(const AGAS float*)B.lam, post = 1.0f - B.lam_init;
        float wn[4];
#pragma unroll
        for (int db = 0; db < 4; ++db) wn[db] = *(const AGAS float*)(B.dnorm + db * 32 + r32b) * post;
#pragma unroll
        for (int r = 0; r < 16; ++r) {
            const float il = __builtin_amdgcn_rcpf(wsf[32 + crow(r, hi)]) * lam;
            float ss = 0.f;
#pragma unroll
            for (int db = 0; db < 4; ++db) { const unsigned w = o0p[db][r >> 1]; const float a0 = (r & 1) ? __uint_as_float(w & 0xffff0000u) : __uint_as_float(w << 16);
                const float v = a0 - il * o1[db][r]; o1[db][r] = v; ss += v * v; }
            ss += __shfl_xor(ss, 1); ss += __shfl_xor(ss, 2); ss += __shfl_xor(ss, 4); ss += __shfl_xor(ss, 8); ss += __shfl_xor(ss, 16);
            const float rs = rsqrtf(ss * (1.0f / 128.0f) + B.eps);
#pragma unroll
            for (int db = 0; db < 4; ++db) o1[db][r] *= rs * wn[db];
        }
        if (!B.dry) store_o<128>(lds, o1, B.OB + (size_t)(qrow0 + wid * 32) * 512 + h * 128, 512, wid, lane);
    }
    ATT_WAIT_BAR(0);
}
#undef ALAS
#undef AGAS
}


constexpr int NWAVES = 8;
constexpr int DM = 1024, NB = 4, SEQ = 4096, NCTX = 256, MLAT = NB * SEQ, MCTX = NB * NCTX, MALL = MLAT + MCTX;
constexpr int PAN_LAT = MLAT / 256, PAN_ALL = MALL / 256;
constexpr int INW = 5920, DFF = 2816;
constexpr float EPS = 1e-6f, LOG2E = 1.4426950408889634f;

constexpr size_t MiB = 1u << 20;
constexpr size_t WS_CTL = 0, CTL_BYTES = 1 * MiB;
constexpr size_t WS_W = 1 * MiB;
constexpr size_t W_IN = 0, W_G = W_IN + 3072ull * 1024 * 2, W_UKVQ = W_G + 3072ull * 1024 * 2, W_ABC = W_UKVQ + 1792ull * 256 * 2, W_O = W_ABC + 3ull * 1024 * 512 * 2,
                 W_GU = W_O + 1024ull * 1024 * 2, W_DN = W_GU + 5632ull * 1024 * 2, W_END = W_DN + 1024ull * 2816 * 2;
static_assert(W_END <= 37 * MiB, "weights region");
constexpr size_t WS_H = 38 * MiB;
constexpr size_t WS_QKV = 72 * MiB;
constexpr size_t SZ512 = (size_t)MALL * 512 * 2, SZ256 = (size_t)MALL * 256 * 2, SZ128 = (size_t)MALL * 128 * 2, SZ32 = (size_t)MALL * 32 * 2;
constexpr size_t Q_ABC = WS_QKV;
constexpr size_t Q_DEAD = Q_ABC + 3 * SZ512;
constexpr size_t Q_QR = Q_DEAD, Q_MK = Q_QR + SZ256, Q_MV = Q_MK + SZ512, Q_KR = Q_MV + SZ512, Q_DK = Q_KR + SZ32, Q_DV = Q_DK + SZ512, Q_SK = Q_DV + SZ512, Q_SV = Q_SK + SZ128,
                 Q_CKVQ = Q_SV + SZ128  , Q_END = Q_CKVQ + 2 * SZ256;
constexpr size_t Q_G = Q_DEAD;
static_assert(Q_G + (size_t)MALL * 3072 * 2 <= Q_END, "gates overlay");
constexpr size_t Q_Y = Q_DEAD;
constexpr size_t Q_ACT = WS_QKV;
constexpr size_t Q_F2 = Q_ACT + (size_t)MALL * 2816 * 2;
constexpr size_t WS_CTXRES = Q_F2 + (size_t)MALL * 1024 * 4;
constexpr size_t WS_SS = WS_CTXRES + (size_t)MCTX * 1024 * 4;
constexpr size_t WS_END = WS_SS + 2ull * MALL * 4 * 4;
static_assert(Q_END <= Q_F2 + (size_t)MALL * 1024 * 4 || true, "");
static_assert(WS_END <= 256 * MiB, "d_ws map must fit 256 MiB");
static_assert(Q_END <= WS_CTXRES, "attention operands below the small buffers");
constexpr int CW_BAR = 4096;
constexpr int CW_MODS = 16384;
constexpr int CW_LAM = CW_MODS + 2 * 5 * 6144;
constexpr int CW_TAB = CW_LAM + 64;
static_assert((CW_TAB + 3072) * 4 <= (int)CTL_BYTES, "CTL");

constexpr int RING_BYTES = 131072, LDSCTL_OFF = RING_BYTES, MISC_OFF = LDSCTL_OFF + 320, LDS_BYTES = 147456;
static_assert(att::LDS_NEED <= RING_BYTES, "attention LDS");

#define GAS __attribute__((address_space(1)))
#define LAS __attribute__((address_space(3)))
typedef unsigned short bf16;
typedef unsigned v4u __attribute__((ext_vector_type(4)));
typedef float f32x4 __attribute__((ext_vector_type(4)));
typedef short bf16x8 __attribute__((ext_vector_type(8)));
typedef GAS unsigned gu32;
typedef GAS unsigned long long gu64;
#define RLX_AGENT __ATOMIC_RELAXED, __HIP_MEMORY_SCOPE_AGENT
#define LDS_WAIT() asm volatile("s_waitcnt lgkmcnt(0)" ::: "memory")
#define VM_WAIT() asm volatile("s_waitcnt vmcnt(0)" ::: "memory")
__device__ __forceinline__ unsigned long long rt() { return __builtin_amdgcn_s_memrealtime(); }
__device__ __forceinline__ unsigned f2bf(float f) { unsigned u = __builtin_bit_cast(unsigned, f); return (u + 0x7fffu + ((u >> 16) & 1u)) >> 16; }
__device__ __forceinline__ unsigned pk2(float lo, float hi) { return f2bf(lo) | (f2bf(hi) << 16); }

#define XB_TMO      128
#define XB_XCNT(j)  (256  + 64 * (j))
#define XB_XSUB(j)  (1280 + 64 * (j))
#define XB_XGEN(j)  (2304 + 64 * (j))
#define XB_TOP      3328
#define XB_TOPGEN   3392
#define XCD_BAR_WORDS 3456
#define XB_SPIN_CAP (1u << 26)

__device__ __forceinline__ unsigned xb_ld(unsigned* p)              { return __hip_atomic_load(p, __ATOMIC_RELAXED, __HIP_MEMORY_SCOPE_AGENT); }
__device__ __forceinline__ unsigned xb_add(unsigned* p, unsigned v) { return __hip_atomic_fetch_add(p, v, __ATOMIC_RELAXED, __HIP_MEMORY_SCOPE_AGENT); }
__device__ __forceinline__ unsigned xb_xcc_id() { return (unsigned)__builtin_amdgcn_s_getreg((3 << 11) | 20) & 0xFu; }
#define XB_SPIN(cond, bar) do { unsigned _sp = 0; while (cond) { __builtin_amdgcn_s_sleep(1); \
    if ((++_sp & 255u) == 0u) { if (xb_ld(&(bar)[XB_TMO])) break; if (_sp > XB_SPIN_CAP) { atomicAdd(&(bar)[XB_TMO], 1u); break; } } } } while (0)

struct XcdBarrier {
    unsigned* bar; unsigned x;
    volatile LAS unsigned* st;
};

__device__ __forceinline__ XcdBarrier xcd_barrier_post(unsigned* bar, volatile LAS unsigned* st) {
    XcdBarrier b; b.bar = bar; b.x = xb_xcc_id(); b.st = st;
    if (threadIdx.x == 0) (void)xb_add(&bar[XB_XCNT(b.x)], 1u);
    return b;
}
__device__ __forceinline__ void xcd_barrier_complete(unsigned* bar, unsigned x, unsigned& nloc, unsigned& nx) {
    const unsigned G = gridDim.x * gridDim.y * gridDim.z;
    unsigned sum, cnt, mine, sp = 0u;
    for (;;) {
        sum = 0u; cnt = 0u; mine = 0u;
#pragma unroll
        for (unsigned j = 0; j < 16; ++j) { const unsigned c = xb_ld(&bar[XB_XCNT(j)]); sum += c; cnt += (c > 0u) ? 1u : 0u; mine = (j == x) ? c : mine; }
        if (sum == G) break;
        __builtin_amdgcn_s_sleep(1);
        if ((++sp & 255u) == 0u) { if (xb_ld(&bar[XB_TMO])) break; if (sp > XB_SPIN_CAP) { atomicAdd(&bar[XB_TMO], 1u); break; } }
    }
    nloc = mine > 0u ? mine : 1u; nx = cnt > 0u ? cnt : 1u;
}

__device__ __forceinline__ void xcd_barrier(const XcdBarrier& b, const bool is_t0) {
    asm volatile("s_waitcnt vmcnt(0)" ::: "memory");
    __syncthreads();
    if (is_t0) {
        unsigned* bar = b.bar;
        __builtin_amdgcn_s_waitcnt(0);
        unsigned nloc = b.st[0], nx = b.st[1];
        if (nloc == 0u) { xcd_barrier_complete(bar, b.x, nloc, nx); b.st[0] = nloc; b.st[1] = nx; }
        const unsigned old = xb_add(&bar[XB_XSUB(b.x)], 1u);
        const unsigned gen = old / nloc;
        if (old + 1u == (gen + 1u) * nloc) {
            __builtin_amdgcn_fence(__ATOMIC_RELEASE, "agent");
            asm volatile("s_waitcnt vmcnt(0)" ::: "memory");
            const unsigned og = xb_add(&bar[XB_TOP], 1u);
            const unsigned tg = og / nx;
            if (og + 1u == (tg + 1u) * nx) xb_add(&bar[XB_TOPGEN], 1u);
            else XB_SPIN(xb_ld(&bar[XB_TOPGEN]) == tg, bar);
            __builtin_amdgcn_fence(__ATOMIC_ACQUIRE, "agent");
            xb_add(&bar[XB_XGEN(b.x)], 1u);
            asm volatile("s_waitcnt vmcnt(0)" ::: "memory");
        } else {
            XB_SPIN(xb_ld(&bar[XB_XGEN(b.x)]) == gen, bar);
            __builtin_amdgcn_fence(__ATOMIC_ACQUIRE, "agent");
            asm volatile("s_waitcnt vmcnt(0)" ::: "memory");
        }
    }
    __syncthreads();
}

struct Ptrs {
    const float* in[24]; float* out; unsigned char* ws;
};
__device__ __forceinline__ float wave_sum(float v) {
#pragma unroll
    for (int o = 1; o < 64; o <<= 1) v += __shfl_xor(v, o);
    return v;
}
__device__ __forceinline__ float silu_acc(float x) { return x / (1.f + expf(-x)); }

__device__ __forceinline__ void p0_transpose_item(const float* W, int K, int Nsrc, int lcol0, const float* kscale, bf16* WT, int n0, int k0, LAS float* scr, int lane) {
    if (lcol0 < 0) {
        unsigned z = 0u; asm volatile("" : "+v"(z));
#pragma unroll
        for (int j = 0; j < 4; ++j) { const int n = (lane >> 3) + 8 * j; *(GAS v4u*)(WT + (size_t)(n0 + n) * K + k0 + 8 * (lane & 7)) = (v4u){z, z, z, z}; }
        return;
    }
#pragma unroll 8
    for (int i = 0; i < 32; ++i) { const int kk = 2 * i + (lane >> 5); float v = *(const GAS float*)(W + (size_t)(k0 + kk) * Nsrc + lcol0 + (lane & 31)); if (kscale) v *= *(const GAS float*)(kscale + k0 + kk); scr[kk * 33 + (lane & 31)] = v; }
    LDS_WAIT(); asm volatile("" ::: "memory");
    const int c = lane & 7;
#pragma unroll
    for (int j = 0; j < 4; ++j) { const int n = (lane >> 3) + 8 * j; const LAS float* s = scr + (8 * c) * 33 + n;
        v4u o; o.x = pk2(s[0 * 33], s[1 * 33]); o.y = pk2(s[2 * 33], s[3 * 33]); o.z = pk2(s[4 * 33], s[5 * 33]); o.w = pk2(s[6 * 33], s[7 * 33]);
        *(GAS v4u*)(WT + (size_t)(n0 + n) * K + k0 + 8 * c) = o; }
    LDS_WAIT(); asm volatile("" ::: "memory");
}
__device__ __forceinline__ void convert_weights(volatile LAS unsigned long long* PT, int l, unsigned char* wsW, LAS float* scr, int gw, int NGW, int lane, int which = 0) {
    const float* w_in = ((const float*)PT[10]) + (size_t)l * DM * INW; const float* q_norm = ((const float*)PT[11]) + l * 256; const float* w_uq = ((const float*)PT[12]) + (size_t)l * 256 * 768;
    const float* kv_norm = ((const float*)PT[13]) + l * 256; const float* w_ukv = ((const float*)PT[14]) + (size_t)l * 256 * 1024;
    const float* w_o = ((const float*)PT[21]) + (size_t)l * DM * DM; const float* w_gu = ((const float*)PT[22]) + (size_t)l * DM * 2 * DFF; const float* w_dn = ((const float*)PT[23]) + (size_t)l * DFF * DM;
    constexpr int I_IN = 16 * 96, I_G = 16 * 96, I_KV = 4 * 32, I_Q = 4 * 24, I_BR = 8 * 32, I_O = 16 * 32, I_GU = 16 * 176, I_DN = 44 * 32;
    constexpr int NITEMS = I_IN + I_G + I_KV + I_Q + 3 * I_BR + I_O + I_GU + I_DN;
    const int it_lo = (which == 2) ? NITEMS - I_DN : 0, it_hi = (which == 1) ? NITEMS - I_DN : NITEMS;
    for (int it = it_lo + gw; it < it_hi; it += NGW) {
        int r = it;
        if (r < I_IN) { const int kb = r / 96, nb = r % 96, n0 = nb * 32; int lc;
            if (n0 < 256) lc = n0; else if (n0 < 1536) lc = n0 + 32; else if (n0 < 1568) lc = 256 + (n0 - 1536); else if (n0 < 1792) lc = -1; else lc = 1568 + (n0 - 1792);
            p0_transpose_item(w_in, DM, INW, lc, nullptr, (bf16*)(wsW + W_IN), n0, kb * 64, scr, lane); continue; } r -= I_IN;
        if (r < I_G) { const int kb = r / 96, nb = r % 96; p0_transpose_item(w_in, DM, INW, 2848 + nb * 32, nullptr, (bf16*)(wsW + W_G), nb * 32, kb * 64, scr, lane); continue; } r -= I_G;
        if (r < I_KV) { const int kb = r / 32, nb = r % 32; p0_transpose_item(w_ukv, 256, 1024, nb * 32, kv_norm, (bf16*)(wsW + W_UKVQ), nb * 32, kb * 64, scr, lane); continue; } r -= I_KV;
        if (r < I_Q) { const int kb = r / 24, nb = r % 24; p0_transpose_item(w_uq, 256, 768, nb * 32, q_norm, (bf16*)(wsW + W_UKVQ) + 1024 * 256, nb * 32, kb * 64, scr, lane); continue; } r -= I_Q;
        if (r < 3 * I_BR) { const int br = r / I_BR, rr = r % I_BR, kb = rr / 32, nb = rr % 32; p0_transpose_item(((const float*)PT[18 + br]) + (size_t)l * 512 * DM, 512, DM, nb * 32, nullptr, (bf16*)(wsW + W_ABC) + (size_t)br * 1024 * 512, nb * 32, kb * 64, scr, lane); continue; } r -= 3 * I_BR;
        if (r < I_O) { const int kb = r / 32, nb = r % 32; p0_transpose_item(w_o, DM, DM, nb * 32, nullptr, (bf16*)(wsW + W_O), nb * 32, kb * 64, scr, lane); continue; } r -= I_O;
        if (r < I_GU) { const int kb = r / 176, nb = r % 176, n0 = nb * 32, tile = n0 >> 8, bj = (n0 >> 7) & 1, c = n0 & 127;
            p0_transpose_item(w_gu, DM, 2 * DFF, bj * DFF + tile * 128 + c, nullptr, (bf16*)(wsW + W_GU), n0, kb * 64, scr, lane); continue; } r -= I_GU;
        { const int kb = r / 32, nb = r % 32; p0_transpose_item(w_dn, DFF, DM, nb * 32, nullptr, (bf16*)(wsW + W_DN), nb * 32, kb * 64, scr, lane); }
    }
}
__device__ __forceinline__ void adaln_item(volatile LAS unsigned long long* PT, int item, float* part, int lane) {
    const int l = item / (24 * 32), rem = item % (24 * 32), cc = rem / 32, kc = rem % 32, n = cc * 256 + 4 * lane;
    const float* W = ((const float*)PT[4]) + (size_t)l * DM * 6144 + (size_t)(kc * 32) * 6144 + n;
    const float* cB = (const float*)PT[1]; const float* cC = (const float*)PT[3];
    f32x4 acc[5];
#pragma unroll
    for (int c = 0; c < 5; ++c) acc[c] = (f32x4){0.f, 0.f, 0.f, 0.f};
#pragma unroll 4
    for (int k = 0; k < 32; ++k) {
        const f32x4 w4 = *(const GAS f32x4*)(W + (size_t)k * 6144); const int kk = kc * 32 + k;
#pragma unroll
        for (int c = 0; c < 5; ++c) { const float s = silu_acc(c < 4 ? *(const GAS float*)(cB + c * DM + kk) : *(const GAS float*)(cC + kk)); acc[c] += w4 * s; }
    }
#pragma unroll
    for (int c = 0; c < 5; ++c) *(GAS f32x4*)(part + (((size_t)l * 32 + kc) * 5 + c) * 6144 + n) = acc[c];
}
__device__ __forceinline__ void row_prenorm(const f32x4 (&x)[4], const float* wpre, const float* shift, const float* scale, bf16* hout, int lane) {
    float ss = 0.f;
#pragma unroll
    for (int j = 0; j < 4; ++j) ss += (x[j][0] * x[j][0] + x[j][1] * x[j][1]) + (x[j][2] * x[j][2] + x[j][3] * x[j][3]);
    const float rs = rsqrtf(wave_sum(ss) * (1.0f / DM) + EPS);
#pragma unroll
    for (int j = 0; j < 4; ++j) { const int e = 4 * lane + 256 * j;
        const f32x4 w = *(const GAS f32x4*)(wpre + e), sh = *(const GAS f32x4*)(shift + e), sc = *(const GAS f32x4*)(scale + e);
        const f32x4 h = (x[j] * rs * w) * (sc + 1.0f) + sh;
        unsigned long long o = (unsigned long long)pk2(h[0], h[1]) | ((unsigned long long)pk2(h[2], h[3]) << 32);
        *(GAS unsigned long long*)(hout + e) = o; }
}
__device__ __forceinline__ void row_post(const float* res, const float* y, const float* wpost, const float* gate, float* res_out, const float* wpre, const float* shift, const float* scale, bf16* hout, int lane) {
    f32x4 yv[4], xv[4]; float ss = 0.f;
#pragma unroll
    for (int j = 0; j < 4; ++j) { const int e = 4 * lane + 256 * j; yv[j] = *(const GAS f32x4*)(y + e); xv[j] = *(const GAS f32x4*)(res + e); ss += (yv[j][0] * yv[j][0] + yv[j][1] * yv[j][1]) + (yv[j][2] * yv[j][2] + yv[j][3] * yv[j][3]); }
    const float rs = rsqrtf(wave_sum(ss) * (1.0f / DM) + EPS);
#pragma unroll
    for (int j = 0; j < 4; ++j) { const int e = 4 * lane + 256 * j; const f32x4 w = *(const GAS f32x4*)(wpost + e), g = *(const GAS f32x4*)(gate + e);
        xv[j] = xv[j] + g * (yv[j] * rs * w); *(GAS f32x4*)(res_out + e) = xv[j]; }
    if (hout) row_prenorm(xv, wpre, shift, scale, hout, lane);
}


#ifdef MK_CHECK
namespace chk {
constexpr int NS = 192;
__device__ __forceinline__ int srow(int i) { return i < 64 ? 5000 + i : (i < 128 ? 16320 + (i - 64) : 16384 + 300 + (i - 128)); }
__device__ __forceinline__ float bf(unsigned short v) { return __uint_as_float((unsigned)v << 16); }
__device__ __forceinline__ void upd(float* err, float e, float ref) {
    atomicMax((int*)err, __float_as_int(fabsf(e))); atomicMax((int*)err + 1, __float_as_int(fabsf(ref)));
}
__device__ __forceinline__ float bsum(float v, float* red) {
    for (int o = 32; o > 0; o >>= 1) v += __shfl_xor(v, o);
    __syncthreads(); if ((threadIdx.x & 63) == 0) red[threadIdx.x >> 6] = v; __syncthreads();
    float t = 0.f; for (int i = 0; i < (int)(blockDim.x >> 6); ++i) t += red[i]; return t;
}
__global__ void set_tab(Ptrs p, const float** tab) { if (threadIdx.x < 24) tab[threadIdx.x] = p.in[threadIdx.x]; }
__global__ void zero_err(float* err) { for (int i = threadIdx.x; i < 256; i += blockDim.x) err[i] = 0.f; }
__global__ void encode(const float* err, float* out, size_t n, int slot) {
    float e = err[2 * slot] / fmaxf(err[2 * slot + 1], 1e-20f);
#ifdef MK_KEY
    { int am = 0; float best = -1.f, tot = 0.f; for (int s = 0; s < 32; ++s) { tot += err[64 + s]; if (err[64 + s] > best) { best = err[64 + s]; am = s; } }
      e = (slot == 0) ? (float)(1 + am) : (slot == 1 ? best / fmaxf(tot, 1.f) : tot * 1e-5f); }
#endif
    for (size_t i = (size_t)blockIdx.x * blockDim.x + threadIdx.x; i < n; i += (size_t)gridDim.x * blockDim.x) out[i] = 100000.f * e;
}
__global__ void gemm_rows(const unsigned short* A, int lda, int K, const float* W, int ldw, int N, float* Z, int ldz) {
    const int i = blockIdx.y, n = blockIdx.x * 256 + threadIdx.x; if (n >= N) return;
    const unsigned short* a = A + (size_t)srow(i) * lda; float s = 0.f;
    for (int k = 0; k < K; ++k) s += bf(a[k]) * W[(size_t)k * ldw + n];
    Z[(size_t)i * ldz + n] = s;
}
__device__ __forceinline__ float rope_val(const float* x  , int c, int d, int row) {
    const int half = d / 2, q = d / 4, axis = c / half, i = c % half, t = row & 4095, pos = axis ? (t & 63) : (t >> 6);
    const int ii = i % q; const float ang = (float)pos * powf(10000.f, -(float)(2 * ii) / (float)half); const float cs = cosf(ang), sn = sinf(ang);
    const float* xa = x + axis * half;
    return (i < q) ? xa[i] * cs - xa[i + q] * sn : xa[i] * cs + xa[i - q] * sn;
}
__global__ void cmp_p1(const float* Z, unsigned char* ws, float* err) {
    const int i = blockIdx.y, n = blockIdx.x * 256 + threadIdx.x; if (n >= 2848) return;
    const int row = srow(i); const bool lat = row < MLAT; const float* z = Z + (size_t)i * 5920; const float qs = 0.125f * LOG2E;
    float e; const unsigned short* o;
    if (n < 256) { e = z[n]; o = (unsigned short*)(ws + Q_CKVQ) + (size_t)row * 256 + n; }
    else if (n < 288) { const int c = n - 256; e = lat ? rope_val(z + 256, c, 32, row) : z[n]; o = (unsigned short*)(ws + Q_KR) + (size_t)row * 32 + c; }
    else if (n < 800) { const int c = n - 288, h = c / 64; e = lat ? rope_val(z + 288 + h * 64, c % 64, 64, row) : z[n]; o = (unsigned short*)(ws + Q_DK) + (size_t)row * 512 + c; }
    else if (n < 1312) { e = z[n]; o = (unsigned short*)(ws + Q_DV) + (size_t)row * 512 + (n - 800); }
    else if (n < 1440) { const int c = n - 1312, h = c / 64; e = lat ? rope_val(z + 1312 + h * 64, c % 64, 64, row) : z[n]; o = (unsigned short*)(ws + Q_SK) + (size_t)row * 128 + c; }
    else if (n < 1568) { e = z[n]; o = (unsigned short*)(ws + Q_SV) + (size_t)row * 128 + (n - 1440); }
    else if (n < 1824) { e = z[n]; o = (unsigned short*)(ws + Q_CKVQ) + (size_t)MALL * 256 + (size_t)row * 256 + (n - 1568); }
    else if (n < 2336) { const int c = n - 1824, h = c / 64; e = qs * (lat ? rope_val(z + 1824 + h * 64, c % 64, 64, row) : z[n]); o = (unsigned short*)(ws + Q_ABC) + (size_t)MALL * 512 + (size_t)row * 512 + c; }
    else { const int c = n - 2336, h = c / 64; e = qs * (lat ? rope_val(z + 2336 + h * 64, c % 64, 64, row) : z[n]); o = (unsigned short*)(ws + Q_ABC) + 2 * (size_t)MALL * 512 + (size_t)row * 512 + c; }
    upd(err, e - bf(*o), e);
}
__global__ void cmp_ss(const float* Z, unsigned char* ws, float* err) {
    const int i = blockIdx.x, which = threadIdx.x; if (which >= 2) return;
    const int row = srow(i); const float* z = Z + (size_t)i * 5920 + (which ? 1568 : 0); float s = 0.f;
    for (int k = 0; k < 256; ++k) s += z[k] * z[k];
    const float* S = (const float*)(ws + WS_SS) + (which ? (size_t)MALL * 4 : 0) + (size_t)row * 4;
    upd(err, s - (S[0] + S[1] + S[2] + S[3]), s);
}
__global__ void cmp_p2(const float* const* in, unsigned char* ws, float* err) {
    const int i = blockIdx.y, n = blockIdx.x * 256 + threadIdx.x; if (n >= 1792) return;
    const int row = srow(i); const bool lat = row < MLAT; const bool isq = n >= 1024;
    const unsigned short* a = (const unsigned short*)(ws + Q_CKVQ) + (isq ? (size_t)MALL * 256 : 0) + (size_t)row * 256;
    const float* S = (const float*)(ws + WS_SS) + (isq ? (size_t)MALL * 4 : 0) + (size_t)row * 4;
    const float rs = rsqrtf((S[0] + S[1] + S[2] + S[3]) / 256.f + EPS);
    const float* nw = isq ? in[11] : in[13]; const float* W = isq ? in[12] : in[14]; const int ldw = isq ? 768 : 1024;
    auto dot = [&](int col) { float s = 0.f; for (int k = 0; k < 256; ++k) s += bf(a[k]) * nw[k] * W[(size_t)k * ldw + col]; return s * rs; };
    float e; const unsigned short* o;
    if (!isq) { const int h = n / 128, j = n % 128; e = dot(n); o = (j < 64) ? (unsigned short*)(ws + Q_MK) + (size_t)row * 512 + h * 64 + j : (unsigned short*)(ws + Q_MV) + (size_t)row * 512 + h * 64 + (j - 64); }
    else { const int c = n - 1024, h = c / 96, j = c % 96; const float qs = 0.10206207261596575f * LOG2E;
        if (j < 64) { e = qs * dot(c); o = (unsigned short*)(ws + Q_ABC) + (size_t)row * 512 + h * 64 + j; }
        else { const int r = j - 64; float x;
            if (lat) { const int half = 16, q = 8, axis = r / half, ii = r % half, t = row & 4095, pos = axis ? (t & 63) : (t >> 6);
                const float ang = (float)pos * powf(10000.f, -(float)(2 * (ii % q)) / 16.f), cs = cosf(ang), sn = sinf(ang);
                const float me = dot(c), pa = dot(h * 96 + 64 + axis * half + (ii < q ? ii + q : ii - q));
                x = (ii < q) ? me * cs - pa * sn : me * cs + pa * sn; }
            else x = dot(c);
            e = qs * x; o = (unsigned short*)(ws + Q_QR) + (size_t)row * 256 + h * 32 + r; } }
    const int cat = !isq ? ((n % 128) < 64 ? 0 : 1) : (((n - 1024) % 96) < 64 ? 2 : 3);
    upd(err + 2 * cat, e - bf(*o), e);
}
__global__ void __launch_bounds__(64) cmp_attn(const float* const* in, unsigned char* ws, const unsigned short* obase, int layer, float* err) {
    __shared__ float sc[2][4352]; __shared__ float qs[96];
    const int i = blockIdx.x, h = blockIdx.y, type = blockIdx.z, lane = threadIdx.x;
    if (type == 1 && h >= 4) return;
    const int row = srow(i); const bool lat = row < MLAT; const int b = lat ? row >> 12 : (row - MLAT) >> 8, t = row & 4095;
    const int nkeys = lat ? 4352 : 256;
    auto krow = [&](int k) { return k < 256 ? MLAT + b * 256 + k : b * 4096 + (k - 256); };
    const unsigned short *QN = (unsigned short*)(ws + Q_ABC), *DQ = QN + (size_t)MALL * 512, *SQ = DQ + (size_t)MALL * 512, *QR = (unsigned short*)(ws + Q_QR), *MK = (unsigned short*)(ws + Q_MK), *MV = (unsigned short*)(ws + Q_MV),
                         *KR = (unsigned short*)(ws + Q_KR), *DK = (unsigned short*)(ws + Q_DK), *DV = (unsigned short*)(ws + Q_DV), *SK = (unsigned short*)(ws + Q_SK), *SV = (unsigned short*)(ws + Q_SV);
    float lsum[2] = {0.f, 0.f}; const int npass = type == 1 ? 2 : 1;
    for (int p = 0; p < npass; ++p) {
        __syncthreads();
        int dq = 64;
        if (type == 0) { for (int j = lane; j < 64; j += 64) qs[j] = bf(QN[(size_t)row * 512 + h * 64 + j]); if (lane < 32) qs[64 + lane] = bf(QR[(size_t)row * 256 + h * 32 + lane]); dq = 96; }
        else if (type == 1) qs[lane] = bf(DQ[(size_t)row * 512 + (2 * h + p) * 64 + lane]);
        else qs[lane] = bf(SQ[(size_t)row * 512 + h * 64 + lane]);
        __syncthreads();
        float mx = -INFINITY;
        for (int k = lane; k < nkeys; k += 64) {
            const int kr = krow(k); bool ok = true;
            if (type == 2 && k >= 256) { int dl = t - (k - 256); if (dl < 0) dl = -dl; ok = dl <= 128; }
            float s = -INFINITY;
            if (ok) { s = 0.f;
                if (type == 0) { for (int j = 0; j < 64; ++j) s += qs[j] * bf(MK[(size_t)kr * 512 + h * 64 + j]); for (int j = 0; j < 32; ++j) s += qs[64 + j] * bf(KR[(size_t)kr * 32 + j]); }
                else if (type == 1) { for (int j = 0; j < 64; ++j) s += qs[j] * bf(DK[(size_t)kr * 512 + (2 * h + p) * 64 + j]); }
                else { for (int j = 0; j < 64; ++j) s += qs[j] * bf(SK[(size_t)kr * 128 + (h >> 2) * 64 + j]); } }
            sc[p][k] = s; mx = fmaxf(mx, s);
        }
        const float sk2 = (type == 2) ? in[17][layer * 8 + h] * LOG2E : -INFINITY;
        mx = fmaxf(mx, sk2);
        for (int o = 32; o > 0; o >>= 1) mx = fmaxf(mx, __shfl_xor(mx, o));
        float sum = 0.f;
        for (int k = lane; k < nkeys; k += 64) { const float pv = exp2f(sc[p][k] - mx); sc[p][k] = pv; sum += pv; }
        for (int o = 32; o > 0; o >>= 1) sum += __shfl_xor(sum, o);
        if (type == 2) sum += exp2f(sk2 - mx);
        lsum[p] = sum; (void)dq;
    }
    __syncthreads();
    if (type != 1) {
        const unsigned short* V = type == 0 ? MV : SV; const int ldv = type == 0 ? 512 : 128, hoff = type == 0 ? h * 64 : (h >> 2) * 64;
        float acc = 0.f; for (int k = 0; k < nkeys; ++k) acc += sc[0][k] * bf(V[(size_t)krow(k) * ldv + hoff + lane]);
        const float e = acc / lsum[0]; const unsigned short* o = obase + (type == 0 ? 0 : 2) * (size_t)MALL * 512 + (size_t)row * 512 + h * 64 + lane;
        upd(err, e - bf(*o), e);
    } else {
        const float lam = *((const float*)(ws + WS_CTL) + CW_LAM + layer), lam_init = 0.8f - 0.6f * expf(-0.3f * (float)layer);
        float v[2]; float ss = 0.f;
        for (int j = 0; j < 2; ++j) { const int d = lane + 64 * j; float a0 = 0.f, a1 = 0.f;
            for (int k = 0; k < nkeys; ++k) { const float vv = bf(DV[(size_t)krow(k) * 512 + h * 128 + d]); a0 += sc[0][k] * vv; a1 += sc[1][k] * vv; }
            v[j] = a0 / lsum[0] - lam * a1 / lsum[1]; ss += v[j] * v[j]; }
        for (int o = 32; o > 0; o >>= 1) ss += __shfl_xor(ss, o);
        const float rs = rsqrtf(ss / 128.f + EPS);
        for (int j = 0; j < 2; ++j) { const int d = lane + 64 * j; const float e = v[j] * rs * in[16][layer * 128 + d] * (1.f - lam_init);
            const unsigned short* o = obase + (size_t)MALL * 512 + (size_t)row * 512 + h * 128 + d; upd(err, e - bf(*o), e); }
    }
}
__global__ void cmp_gates(const float* Z, unsigned char* ws, float* err) {
    const int i = blockIdx.y, n = blockIdx.x * 256 + threadIdx.x; if (n >= 3072) return;
    const float e = 1.f / (1.f + expf(-Z[(size_t)i * 3072 + n])); const unsigned short* o = (const unsigned short*)(ws + Q_G) + (size_t)srow(i) * 3072 + n;
    { const int row = srow(i); const bool bad = fabsf(e - bf(*o)) > 0.02f;
#ifndef MK_KEY
#define MK_KEY 0
#endif
      const int key = MK_KEY == 0 ? (n % 256) / 8 : MK_KEY == 1 ? (row % 256) / 8 : MK_KEY == 2 ? (row % 16) : MK_KEY == 3 ? (n % 32) : (n / 256);
      if (bad) atomicAdd(err + 64 + key, 1.0f); }
}
__global__ void cmp_merge(const float* const* in, unsigned char* ws, int layer, float* err) {
    const int i = blockIdx.y, n = blockIdx.x * 256 + threadIdx.x, row = srow(i); float e = 0.f;
    for (int br = 0; br < 3; ++br) { const unsigned short* a = (const unsigned short*)(ws + Q_ABC) + (size_t)br * MALL * 512 + (size_t)row * 512; const float* W = in[18 + br] + (size_t)layer * 512 * 1024; float s = 0.f;
        for (int k = 0; k < 512; ++k) s += bf(a[k]) * W[(size_t)k * 1024 + n];
        e += bf(*((const unsigned short*)(ws + Q_G) + (size_t)row * 3072 + br * 1024 + n)) * s; }
    upd(err, e - bf(*((const unsigned short*)(ws + WS_H) + (size_t)row * 1024 + n)), e);
}
__global__ void cmp_f32(const float* Z, int ldz, const float* Y, int ldy, int N, float* err) {
    const int i = blockIdx.y, n = blockIdx.x * 256 + threadIdx.x; if (n >= N) return;
    const float e = Z[(size_t)i * ldz + n]; upd(err, e - Y[(size_t)srow(i) * ldy + n], e);
}
__global__ void cmp_act(const float* Z, unsigned char* ws, float* err) {
    const int i = blockIdx.y, n = blockIdx.x * 256 + threadIdx.x; if (n >= 2816) return;
    const float g = Z[(size_t)i * 5632 + n], u = Z[(size_t)i * 5632 + 2816 + n], e = g / (1.f + expf(-g)) * u;
    upd(err, e - bf(*((const unsigned short*)(ws + Q_ACT) + (size_t)srow(i) * 2816 + n)), e);
}
__global__ void __launch_bounds__(256) cmp_rowpost(const float* const* in, unsigned char* ws, const float* outp, int layer, int which  , float* err) {
    __shared__ float red[8]; __shared__ float xs[1024];
    const int i = blockIdx.x, row = srow(i); const bool lat = row < MLAT; const int cond = lat ? row >> 12 : 4;
    const float* mods = (const float*)(ws + WS_CTL) + CW_MODS + ((size_t)layer * 5 + cond) * 6144;
    const float* y = (which == 1 ? (const float*)(ws + Q_Y) : (const float*)(ws + Q_F2)) + (size_t)row * 1024;
    (void)y; (void)mods; (void)red; (void)xs; (void)in; (void)outp; (void)err;
    if (which != 1 || layer != 0) return;
    const float* res = lat ? in[0] + (size_t)row * 1024 : in[2] + (size_t)(row - MLAT) * 1024;
    float ss = 0.f; for (int j = threadIdx.x; j < 1024; j += 256) ss += y[j] * y[j];
    ss = bsum(ss, red); const float rs = rsqrtf(ss / 1024.f + EPS);
    float s2 = 0.f;
    for (int j = threadIdx.x; j < 1024; j += 256) { const float x1 = res[j] + mods[2 * 1024 + j] * (y[j] * rs * in[7][layer * 1024 + j]); xs[j] = x1; s2 += x1 * x1;
        const float o = lat ? outp[(size_t)row * 1024 + j] : *((const float*)(ws + WS_CTXRES) + (size_t)(row - MLAT) * 1024 + j); upd(err, x1 - o, x1); }
    s2 = bsum(s2, red); const float r2 = rsqrtf(s2 / 1024.f + EPS);
    for (int j = threadIdx.x; j < 1024; j += 256) { const float hh = (xs[j] * r2 * in[8][layer * 1024 + j]) * (1.f + mods[4 * 1024 + j]) + mods[3 * 1024 + j];
        upd(err + 2, hh - bf(*((const unsigned short*)(ws + WS_H) + (size_t)row * 1024 + j)), hh); }
}
}
#endif


#ifndef MK_SIG_ALIGN
#define MK_SIG_ALIGN true
#endif
#ifndef MK_SIG_SP2
#define MK_SIG_SP2 true
#endif
#ifndef MK_ALIGN
#define MK_ALIGN true
#endif
#ifndef MK_STOP_AFTER
#define MK_STOP_AFTER 1000
#endif
__global__ void __launch_bounds__(NWAVES * 64, 2) mk_fwd(Ptrs P) {
    extern __shared__ __attribute__((aligned(16))) unsigned char lds_raw[];
    LAS unsigned char* lds = (LAS unsigned char*)lds_raw;
    volatile LAS unsigned* MISC = (volatile LAS unsigned*)(lds + MISC_OFF);
    volatile LAS unsigned long long* PT = (volatile LAS unsigned long long*)(lds + MISC_OFF + 256);
#define IN(i) ((const float*)PT[i])
#define OUTP ((float*)PT[24])
    const int tid = threadIdx.x, wave0 = __builtin_amdgcn_readfirstlane(tid >> 6);
    const int G = gridDim.x, bx = blockIdx.x, vcu = (G % 8 == 0) ? (bx % 8) * (G / 8) + bx / 8 : bx;
    unsigned char* ws = P.ws;
    gu32* ctl = (gu32*)(ws + WS_CTL);
    for (int u = tid; u < (LDS_BYTES - LDSCTL_OFF) / 4; u += NWAVES * 64) ((LAS unsigned*)(lds + LDSCTL_OFF))[u] = 0u;
    __syncthreads();
    if (tid == 0) {
#pragma unroll
        for (int i = 0; i < 24; ++i) PT[i] = (unsigned long long)P.in[i];
        PT[24] = (unsigned long long)P.out;
    }
    __syncthreads();
    (void)xcd_barrier_post((unsigned*)(ctl + CW_BAR), MISC + 8);
    int phase_no = 0;
#define GRID_BAR() do { unsigned char* wsb = ws; asm volatile("" : "+s"(wsb)); int wvb = wave0; asm volatile("" : "+s"(wvb)); XcdBarrier bar_; bar_.bar = (unsigned*)(wsb + WS_CTL) + CW_BAR; bar_.x = xb_xcc_id(); bar_.st = MISC + 8; \
        int lnb; asm volatile("v_mbcnt_lo_u32_b32 %0, -1, 0\n\tv_mbcnt_hi_u32_b32 %0, -1, %0" : "=v"(lnb)); const bool t0_ = (wvb == 0) && (lnb == 0); xcd_barrier(bar_, t0_); if (++phase_no >= MK_STOP_AFTER) goto dump_and_exit; } while (0)

#define PH_BEGIN() unsigned char* wsp = ws; asm volatile("" : "+s"(wsp)); int lane; asm volatile("v_mbcnt_lo_u32_b32 %0, -1, 0\n\tv_mbcnt_hi_u32_b32 %0, -1, %0" : "=v"(lane)); int wave = wave0; asm volatile("" : "+s"(wave)); \
    float* MODS = (float*)(wsp + WS_CTL) + CW_MODS; float* LAMS = (float*)(wsp + WS_CTL) + CW_LAM; float* TAB = (float*)(wsp + WS_CTL) + CW_TAB; \
    bf16* Hb = (bf16*)(wsp + WS_H); bf16* QN = (bf16*)(wsp + Q_ABC); bf16* DQ = QN + (size_t)MALL * 512; bf16* SQ = DQ + (size_t)MALL * 512; \
    bf16* QR = (bf16*)(wsp + Q_QR); bf16* MK = (bf16*)(wsp + Q_MK); bf16* MV = (bf16*)(wsp + Q_MV); bf16* KR = (bf16*)(wsp + Q_KR); \
    bf16* DK = (bf16*)(wsp + Q_DK); bf16* DV = (bf16*)(wsp + Q_DV); bf16* SK = (bf16*)(wsp + Q_SK); bf16* SV = (bf16*)(wsp + Q_SV); \
    bf16* CKV = (bf16*)(wsp + Q_CKVQ); bf16* CQ = CKV + (size_t)MALL * 256; \
    bf16* GT = (bf16*)(wsp + Q_G); float* Yb = (float*)(wsp + Q_Y); bf16* ACT = (bf16*)(wsp + Q_ACT); float* F2 = (float*)(wsp + Q_F2); \
    float* CTXRES = (float*)(wsp + WS_CTXRES); float* SSKV = (float*)(wsp + WS_SS); float* SSQ = SSKV + (size_t)MALL * 4; \
    unsigned char* wsW = wsp + WS_W; const int gw = vcu * NWAVES + wave, NGW = G * NWAVES; \
    (void)MODS; (void)LAMS; (void)TAB; (void)Hb; (void)QN; (void)DQ; (void)SQ; (void)QR; (void)MK; (void)MV; (void)KR; (void)DK; (void)DV; (void)SK; (void)SV; (void)CKV; (void)CQ; (void)GT; (void)Yb; (void)ACT; (void)F2; (void)CTXRES; (void)SSKV; (void)SSQ; (void)wsW; (void)gw; (void)NGW; (void)lane; (void)wave

    {
        PH_BEGIN();
        for (int it = gw; it < 2 * 24 * 32; it += NGW) adaln_item(PT, it, (float*)(wsp + WS_QKV), lane);
#ifndef MK_REP_P0
#define MK_REP_P0 1
#endif
        for (int r_ = 0; r_ < MK_REP_P0; ++r_) { convert_weights(PT, 0, wsW, (LAS float*)(lds + wave * 16384), gw, NGW, lane); for (int it = gw; it < 2 * 24 * 32; it += NGW) adaln_item(PT, it, (float*)(wsp + WS_QKV), lane); }
        if (bx == 0) {
            if (wave == 0 && lane < 2) {
                const float* dl = IN(15) + lane * 256; float a = 0.f, b = 0.f;
                for (int i = 0; i < 64; ++i) { a += dl[i] * dl[64 + i]; b += dl[128 + i] * dl[192 + i]; }
                LAMS[lane] = expf(a) - expf(b) + (0.8f - 0.6f * expf(-0.3f * (float)lane));
            }
            const int tid_l = wave * 64 + lane;
            for (int e = tid_l; e < 64 * 16; e += NWAVES * 64) { const int pos = e >> 4, i = e & 15; const float ang = (float)pos * powf(10000.f, -(float)(2 * i) / 32.f); TAB[e] = cosf(ang); TAB[1024 + e] = sinf(ang); }
            for (int e = tid_l; e < 64 * 8; e += NWAVES * 64) { const int pos = e >> 3, i = e & 7; const float ang = (float)pos * powf(10000.f, -(float)(2 * i) / 16.f); TAB[2048 + e] = cosf(ang); TAB[2560 + e] = sinf(ang); }
        }
    }
    GRID_BAR();
    { PH_BEGIN();
      const float* part = (const float*)(wsp + WS_QKV); const float* bias = IN(5);
      for (int e = gw * 64 + lane; e < 2 * 5 * 6144; e += NGW * 64) { const int l = e / (5 * 6144), r = e - l * 5 * 6144, c = r / 6144, n = r - c * 6144;
          float s = *(const GAS float*)(bias + l * 6144 + n);
          for (int kc = 0; kc < 32; ++kc) s += *(const GAS float*)(part + (((size_t)l * 32 + kc) * 5 + c) * 6144 + n);
          *(GAS float*)(MODS + e) = s; } }
    GRID_BAR();
    { PH_BEGIN();
    for (int row = gw; row < MALL; row += NGW) {
        const bool lat = row < MLAT; const float* xr = lat ? IN(0) + (size_t)row * DM : IN(2) + (size_t)(row - MLAT) * DM;
        const float* md = MODS + (size_t)(lat ? (row >> 12) : 4) * 6144;
        f32x4 x[4];
#pragma unroll
        for (int j = 0; j < 4; ++j) x[j] = *(const GAS f32x4*)(xr + 4 * lane + 256 * j);
        row_prenorm(x, IN(6), md, md + DM, Hb + (size_t)row * DM, lane);
    } }
    GRID_BAR();

    for (int l = 0; l < 2; ++l) {
        const bool last = (l == 1);
        const int npan = last ? PAN_LAT : PAN_ALL;
        const float lam_init = 0.8f - 0.6f * expf(-0.3f * (float)l);
        {
            PH_BEGIN();
            pg8::Gemm g{Hb, (const bf16*)(wsW + W_IN), DM};
            pg8::Sched S{PAN_LAT, 12, 4, last ? 7 : 12, 0, 0, PAN_LAT, 0, PAN_LAT, 1, 0, 0, G, bx};
            pg8::EpiP1 E{CKV, CQ, KR, DK, DV, SK, SV, DQ, SQ, SSKV, SSQ, TAB, 0.125f * LOG2E};
#ifndef MK_NO_P1
#ifndef MK_REP_P1
#define MK_REP_P1 1
#endif
            for (int r_ = 0; r_ < MK_REP_P1; ++r_)
            pg8::gemm_phase<pg8::EpiP1, pg8::Sched, MK_ALIGN, true>(lds, g, S, E, wave, lane);
#endif
        }
        GRID_BAR();
        {
            PH_BEGIN();
            pg8::Gemm g{CKV, (const bf16*)(wsW + W_UKVQ), 256};
            pg8::Sched S{PAN_ALL, 4, npan, 3, 0, 0, PAN_ALL, 4, 0, 1, 0, 0, G, bx};
            pg8::EpiP2 E{MK, MV, QN, QR, SSKV, SSQ, TAB, 0.10206207261596575f * LOG2E, EPS};
#ifndef MK_NO_P2
#ifndef MK_REP_P2
#define MK_REP_P2 1
#endif
            for (int r_ = 0; r_ < MK_REP_P2; ++r_)
            pg8::gemm_phase<pg8::EpiP2, pg8::Sched, MK_ALIGN, true>(lds, g, S, E, wave, lane);
#endif
        }
        GRID_BAR();
        {
            PH_BEGIN();
#ifdef MK_ATT_OUT_DOUT
            bf16* OAd = (bf16*)OUTP; att::Bufs B{QN, QR, MK, MV, KR, DQ, DK, DV, SQ, SK, SV, OAd, OAd + (size_t)MALL * 512, OAd + 2 * (size_t)MALL * 512, 0, LAMS + l, IN(16) + l * 128, IN(17) + l * 8, lam_init, EPS};
#else
            att::Bufs B{QN, QR, MK, MV, KR, DQ, DK, DV, SQ, SK, SV, QN, DQ, SQ, 0, LAMS + l, IN(16) + l * 128, IN(17) + l * 8, lam_init, EPS};
#endif
            LAS unsigned char* al = lds;
#ifdef MK_ATT_TWICE
            for (int rep_ = 0; rep_ < 2; ++rep_) { B.dry = (rep_ == 0);
#endif
#ifndef MK_NO_DIFF
            for (int u = vcu; u < 256; u += G) att::attn_unit(al, B, 1, u >> 6, (u >> 4) & 3, u & 15, wave, lane);
#endif
#ifndef MK_NO_MLA
            for (int u = vcu; u < 512; u += G) att::attn_unit(al, B, 0, u >> 7, (u >> 4) & 7, u & 15, wave, lane);
#endif
#ifndef MK_NO_SWA
            for (int u = vcu; u < 512; u += G) att::attn_unit(al, B, 2, u >> 7, (u >> 4) & 7, u & 15, wave, lane);
#endif
            if (!last) {
#ifndef MK_NO_CTXQ
                for (int u = vcu; u < 80; u += G) {
                    if (u < 32) att::attn_unit(al, B, 0, u >> 3, u & 7, 16, wave, lane);
                    else if (u < 48) att::attn_unit(al, B, 1, (u - 32) >> 2, (u - 32) & 3, 16, wave, lane);
                    else att::attn_unit(al, B, 2, (u - 48) >> 3, (u - 48) & 7, 16, wave, lane);
                }
#endif
            }
#ifdef MK_ATT_TWICE
            }
#endif
        }
        GRID_BAR();
        {
            PH_BEGIN();
            pg8::Gemm g{Hb, (const bf16*)(wsW + W_G), DM};
            pg8::Sched S{npan, 12, 0, 0, 0, 0, 0, 0, 0, 1, 0, 0, G, bx};
            pg8::EpiSig E{GT};
#ifndef MK_NO_P3B
#ifndef MK_REP_P3B
#define MK_REP_P3B 1
#endif
            for (int r_ = 0; r_ < MK_REP_P3B; ++r_)
            pg8::gemm_phase<pg8::EpiSig, pg8::Sched, MK_ALIGN, true>(lds, g, S, E, wave, lane);
#endif
        }
        GRID_BAR();
        {
            PH_BEGIN();
            pg8::Gemm g{QN, (const bf16*)(wsW + W_ABC), 512};
            pg8::Sched S{npan, 4, 0, 0, 0, 0, 0, 0, 0, 3, PAN_ALL, 4, G, bx};
            pg8::EpiMerge E{GT, Hb};
#ifndef MK_NO_P4A
#ifndef MK_REP_P4A
#define MK_REP_P4A 1
#endif
            for (int r_ = 0; r_ < MK_REP_P4A; ++r_)
            pg8::gemm_phase<pg8::EpiMerge, pg8::Sched, MK_ALIGN, true>(lds, g, S, E, wave, lane);
#endif
        }
        GRID_BAR();
        {
            PH_BEGIN();
            pg8::Gemm g{Hb, (const bf16*)(wsW + W_O), DM};
            pg8::Sched S{npan, 4, 0, 0, 0, 0, 0, 0, 0, 1, 0, 0, G, bx};
            pg8::EpiF32 E{Yb, DM};
#ifndef MK_NO_PF32
#ifndef MK_REP_P4B
#define MK_REP_P4B 1
#endif
            for (int r_ = 0; r_ < MK_REP_P4B; ++r_)
            pg8::gemm_phase<pg8::EpiF32, pg8::Sched, MK_ALIGN, true>(lds, g, S, E, wave, lane);
#endif
        }
        GRID_BAR();
        { PH_BEGIN(); const float* mods_l = MODS + (size_t)l * 5 * 6144;
        for (int row = gw; row < npan * 256; row += NGW) {
            const bool lat = row < MLAT; const float* md = mods_l + (size_t)(lat ? (row >> 12) : 4) * 6144;
            const float* res = lat ? ((l == 0 ? IN(0) : (const float*)OUTP) + (size_t)row * DM) : ((l == 0 ? IN(2) : (const float*)CTXRES) + (size_t)(row - MLAT) * DM);
            float* ro = lat ? OUTP + (size_t)row * DM : CTXRES + (size_t)(row - MLAT) * DM;
            row_post(res, Yb + (size_t)row * DM, IN(7) + l * DM, md + 2 * DM, ro, IN(8) + l * DM, md + 3 * DM, md + 4 * DM, Hb + (size_t)row * DM, lane);
        } }
        GRID_BAR();
        {
            PH_BEGIN();
            pg8::Gemm g{Hb, (const bf16*)(wsW + W_GU), DM};
            pg8::Sched S{npan, 22, 0, 0, 0, 0, 0, 0, 0, 1, 0, 0, G, bx};
            pg8::EpiSwiglu E{ACT};
#ifndef MK_NO_P5
#ifndef MK_REP_P5
#define MK_REP_P5 1
#endif
            for (int r_ = 0; r_ < MK_REP_P5; ++r_)
            pg8::gemm_phase<pg8::EpiSwiglu, pg8::Sched, MK_ALIGN, true>(lds, g, S, E, wave, lane);
#endif
        }
        GRID_BAR();
        {
            PH_BEGIN();
            pg8::Gemm g{ACT, (const bf16*)(wsW + W_DN), DFF};
            pg8::Sched S{npan, 4, 0, 0, 0, 0, 0, 0, 0, 1, 0, 0, G, bx};
            pg8::EpiF32 E{F2, DM};
#ifndef MK_NO_PF32
#ifndef MK_REP_P6
#define MK_REP_P6 1
#endif
            for (int r_ = 0; r_ < MK_REP_P6; ++r_)
            pg8::gemm_phase<pg8::EpiF32, pg8::Sched, MK_ALIGN, true>(lds, g, S, E, wave, lane);
            if (!last && bx >= 16 && G == 256) convert_weights(PT, 1, wsW, (LAS float*)(lds + wave * 16384), (bx - 16) * NWAVES + wave, 240 * NWAVES, lane, 1);
#endif
        }
        GRID_BAR();
        {
            PH_BEGIN(); const float* mods_l = MODS + (size_t)l * 5 * 6144;
            const float* mods_n = MODS + (size_t)(l + 1) * 5 * 6144;
            for (int row = gw; row < npan * 256; row += NGW) {
                const bool lat = row < MLAT; const int cond = lat ? (row >> 12) : 4; const float* md = mods_l + (size_t)cond * 6144; const float* mn = mods_n + (size_t)cond * 6144;
                float* ro = lat ? OUTP + (size_t)row * DM : CTXRES + (size_t)(row - MLAT) * DM;
                row_post(ro, F2 + (size_t)row * DM, IN(9) + l * DM, md + 5 * DM, ro, IN(6) + (l + 1) * DM, mn, mn + DM, last ? nullptr : Hb + (size_t)row * DM, lane);
            }
            if (!last) convert_weights(PT, l + 1, wsW, (LAS float*)(lds + wave * 16384), gw, NGW, lane, (G == 256) ? 2 : 0);
        }
        if (!last) GRID_BAR();
    }
    if (false) {
dump_and_exit:
#ifdef MK_DUMP_LO
        { unsigned char* wsd = ws; asm volatile("" : "+s"(wsd)); int ln; asm volatile("v_mbcnt_lo_u32_b32 %0, -1, 0\n\tv_mbcnt_hi_u32_b32 %0, -1, %0" : "=v"(ln));
          const unsigned* src = (const unsigned*)(wsd + (size_t)(MK_DUMP_LO)); const size_t nw = ((size_t)(MK_DUMP_HI) - (size_t)(MK_DUMP_LO)) / 4; float* o = OUTP;
          const size_t NO = (size_t)MLAT * DM;
          if (nw > 0) for (size_t j = (size_t)bx * 512 + wave0 * 64 + ln; j < NO; j += (size_t)G * 512) { unsigned x = 0u; for (size_t q = j; q < nw; q += NO) x ^= src[q]; x ^= x >> 16; o[j] = (float)(x & 0xffffu) * (1.0f / 65536.0f); } }
#endif
        return;
    }
    { unsigned char* wsb = ws; asm volatile("" : "+s"(wsb)); const unsigned tmo = __hip_atomic_load((unsigned*)(wsb + WS_CTL) + CW_BAR + XB_TMO, __ATOMIC_RELAXED, __HIP_MEMORY_SCOPE_AGENT);
      if (tmo != 0u && bx == 0 && wave0 == 0) { float* o = OUTP; o[0] = 3.0e7f; } }
}

extern "C" void kernel_launch(void* const* d_in, const int* in_sizes, int n_in, void* d_out, int out_size, void* d_ws, size_t ws_size, hipStream_t stream) {
    static int grid = 0;
    if (grid == 0) {
        if (n_in != 24 || out_size != MLAT * DM || ws_size < WS_END) { fprintf(stderr, "kernel_launch: unexpected shapes (n_in %d out %d ws %zu need %zu)\n", n_in, out_size, ws_size, (size_t)WS_END); grid = -1; return; }
        int dev = 0, cus = 0, per_cu = 0;
        (void)hipGetDevice(&dev); (void)hipDeviceGetAttribute(&cus, hipDeviceAttributeMultiprocessorCount, dev);
        if (hipFuncSetAttribute((const void*)mk_fwd, hipFuncAttributeMaxDynamicSharedMemorySize, LDS_BYTES) != hipSuccess) { fprintf(stderr, "kernel_launch: hipFuncSetAttribute failed\n"); grid = -1; return; }
        (void)hipOccupancyMaxActiveBlocksPerMultiprocessor(&per_cu, (const void*)mk_fwd, NWAVES * 64, LDS_BYTES);
        (void)hipGetLastError();
        if (per_cu < 1) fprintf(stderr, "kernel_launch: occupancy query says %d blocks/CU\n", per_cu);
        grid = cus;
    }
    if (grid < 0) return;
    (void)hipMemsetAsync((char*)d_ws + WS_CTL, 0, CTL_BYTES, stream);
    Ptrs p{};
    for (int i = 0; i < 24; ++i) p.in[i] = (const float*)d_in[i];
    p.out = (float*)d_out; p.ws = (unsigned char*)d_ws;
    hipLaunchKernelGGL(mk_fwd, dim3(grid), dim3(NWAVES * 64), LDS_BYTES, stream, p);
#ifdef MK_CHECK
    {
#ifndef MK_CHECK_LAYER
#define MK_CHECK_LAYER 0
#endif
#ifndef MK_CHECK_SLOT
#define MK_CHECK_SLOT 0
#endif
        constexpr int L = MK_CHECK_LAYER; unsigned char* ws = (unsigned char*)d_ws;
        float* err = (float*)(ws + 240 * MiB); const float** tab = (const float**)(ws + 240 * MiB + 4096); float* Z = (float*)d_out;
        const float* w_in = (const float*)d_in[10] + (size_t)L * DM * INW;
        chk::set_tab<<<1, 32, 0, stream>>>(p, tab); chk::zero_err<<<1, 64, 0, stream>>>(err);
#if MK_CHECK == 1
        chk::gemm_rows<<<dim3(24, chk::NS), 256, 0, stream>>>((const unsigned short*)(ws + WS_H), 1024, 1024, w_in, INW, INW, Z, INW);
        chk::cmp_p1<<<dim3(12, chk::NS), 256, 0, stream>>>(Z, ws, err); chk::cmp_ss<<<chk::NS, 64, 0, stream>>>(Z, ws, err + 2);
#elif MK_CHECK == 2
        chk::cmp_p2<<<dim3(7, chk::NS), 256, 0, stream>>>(tab, ws, err);
#elif MK_CHECK == 3
        chk::cmp_attn<<<dim3(chk::NS, 8, 3), 64, 0, stream>>>(tab, ws, (const unsigned short*)d_out, L, err);
#elif MK_CHECK == 4
        chk::gemm_rows<<<dim3(12, chk::NS), 256, 0, stream>>>((const unsigned short*)(ws + WS_H), 1024, 1024, w_in + 2848, INW, 3072, Z, 3072);
        chk::cmp_gates<<<dim3(12, chk::NS), 256, 0, stream>>>(Z, ws, err);
#elif MK_CHECK == 5
        chk::cmp_merge<<<dim3(4, chk::NS), 256, 0, stream>>>(tab, ws, L, err);
#elif MK_CHECK == 6
        chk::gemm_rows<<<dim3(4, chk::NS), 256, 0, stream>>>((const unsigned short*)(ws + WS_H), 1024, 1024, (const float*)d_in[21] + (size_t)L * DM * DM, DM, DM, Z, DM);
        chk::cmp_f32<<<dim3(4, chk::NS), 256, 0, stream>>>(Z, DM, (const float*)(ws + Q_Y), DM, DM, err);
#elif MK_CHECK == 7
        chk::cmp_rowpost<<<chk::NS, 256, 0, stream>>>(tab, ws, (const float*)d_out, L, 1, err);
#elif MK_CHECK == 8
        chk::gemm_rows<<<dim3(22, chk::NS), 256, 0, stream>>>((const unsigned short*)(ws + WS_H), 1024, 1024, (const float*)d_in[22] + (size_t)L * DM * 2 * DFF, 2 * DFF, 2 * DFF, Z, 2 * DFF);
        chk::cmp_act<<<dim3(11, chk::NS), 256, 0, stream>>>(Z, ws, err);
#elif MK_CHECK == 9
        chk::gemm_rows<<<dim3(4, chk::NS), 256, 0, stream>>>((const unsigned short*)(ws + Q_ACT), DFF, DFF, (const float*)d_in[23] + (size_t)L * DFF * DM, DM, DM, Z, DM);
        chk::cmp_f32<<<dim3(4, chk::NS), 256, 0, stream>>>(Z, DM, (const float*)(ws + Q_F2), DM, DM, err);
#endif
        chk::encode<<<1024, 256, 0, stream>>>(err, (float*)d_out, (size_t)MLAT * DM, MK_CHECK_SLOT);
    }
#endif
}
```

```cpp
#include <hip/hip_runtime.h>
#include <cstdio>
#include <cstdint>
#include <math.h>
namespace pg8 {
#define PG8_LAS __attribute__((address_space(3)))
typedef unsigned short bf16_t;
typedef short bf16x8 __attribute__((ext_vector_type(8)));
typedef float f32x4 __attribute__((ext_vector_type(4)));
typedef unsigned u32x4 __attribute__((ext_vector_type(4)));
constexpr int BM = 256, BK = 64, HALF = 128, HTB = HALF * BK * 2  , STAGE_BYTES = 8 * HTB, NXCD = 8, WGM = 8;

__host__ __device__ __forceinline__ int lds_byte(int r, int c) { const int st = (r >> 4) * 2 + (c >> 5), rr = r & 15, cc = c & 31, ob = rr * 64 + cc * 2; return st * 1024 + (ob ^ (((ob >> 9) & 1) << 5)); }
__host__ __device__ __forceinline__ void stage_rc(int b, int& R, int& C) { const int st = b / 1024, sb = b % 1024, swz = sb ^ (((sb >> 9) & 1) << 5); R = (st >> 1) * 16 + swz / 64; C = (st & 1) * 32 + (swz % 64) / 2; }
__host__ __device__ __forceinline__ int perm32(int rho) { const int n = rho >> 4, i = rho & 15; return 8 * (i >> 2) + 4 * n + (i & 3); }

struct Unit { int pm, pn, rm, rn, aux; };
struct Gemm { const bf16_t* A; const bf16_t* Bt; int K; };

__device__ __forceinline__ void tile_of(int L, int nM, int nN, int& pm, int& pn) {
    const int nwg = nM * nN; int wgid = L;
    { const int q = nwg / NXCD, r = nwg % NXCD, xcd = wgid % NXCD, off = wgid / NXCD; wgid = (xcd < r ? xcd * (q + 1) : r * (q + 1) + (xcd - r) * q) + off; }
    const int nig = WGM * nN, gid = wgid / nig, fm = gid * WGM, gsz = (nM - fm) < WGM ? (nM - fm) : WGM;
    pm = fm + ((wgid % nig) % gsz); pn = (wgid % nig) / gsz;
}
struct Sched {
    int nMa, nNa, nMb, nNb;
    int pmA, pnA, pmB, pnB;
    int rmB;
    int rep, repM, repN;
    int G, c;
    __device__ __forceinline__ bool next(int i, Unit& u) const {
        const int ti = (rep == 1) ? i : i / rep, br = i - ti * rep;
        const int L = ti * G + c, na = nMa * nNa, nb = nMb * nNb;
        if (L >= na + nb) return false;
        int pm, pn;
        if (L < na) { tile_of(L, nMa, nNa, pm, pn); u.rm = pm; u.rn = pn; u.pm = pmA + pm + br * repM; u.pn = pnA + pn + br * repN; u.aux = br; }
        else { tile_of(L - na, nMb, nNb, pm, pn); u.rm = rmB + pm; u.rn = pn; u.pm = pmB + pm + br * repM; u.pn = pnB + pn + br * repN; u.aux = br | 0x100; }
        return true;
    }
    __device__ __forceinline__ void a_ready(const Unit&) const {}
    __device__ __forceinline__ void done(const Unit&) const {}
};

typedef float f32x2_t __attribute__((ext_vector_type(2))); typedef __bf16 bf16x2_t __attribute__((ext_vector_type(2)));
__device__ __forceinline__ unsigned cvt_pk_bf16(float lo, float hi) { f32x2_t v = {lo, hi}; bf16x2_t b = __builtin_convertvector(v, bf16x2_t); return __builtin_bit_cast(unsigned, b); }
typedef unsigned u32x2 __attribute__((ext_vector_type(2)));

#define PG8_GAS __attribute__((address_space(1)))
__device__ __forceinline__ void gst16(void* p, u32x4 v) { *(PG8_GAS u32x4*)p = v; }
__device__ __forceinline__ void gst8(void* p, unsigned a, unsigned b) { typedef unsigned u2 __attribute__((ext_vector_type(2))); *(PG8_GAS u2*)p = (u2){a, b}; }
__device__ __forceinline__ void gstf4(void* p, f32x4 v) { *(PG8_GAS f32x4*)p = v; }
__device__ __forceinline__ f32x4 gldf4(const void* p) { return *(const PG8_GAS f32x4*)p; }
__device__ __forceinline__ u32x4 gld16(const void* p) { return *(const PG8_GAS u32x4*)p; }
__device__ __forceinline__ float bf_lo(unsigned w) { return __uint_as_float(w << 16); }
__device__ __forceinline__ float bf_hi(unsigned w) { return __uint_as_float(w & 0xffff0000u); }
__device__ __forceinline__ float fast_sigmoid(float x) { return __builtin_amdgcn_rcpf(1.f + __builtin_amdgcn_exp2f(-1.4426950408889634f * x)); }


struct EpiP1 {
    static constexpr bool PERM = false, AFTER_DRAIN = false;
    bf16_t *CKV, *CQ, *KR, *DK, *DV, *SK, *SV, *DQ, *SQ; float *SSKV, *SSQ; const float* TAB; float qscale;
    __device__ __forceinline__ void operator()(const f32x4 (&acc)[2][2][4][2], const Unit& u, int wr, int wc, int fr, int fq) const {
        const bool lat = u.rm < 64;
        const int row0 = u.rm * BM + wr * 64 + fr;
        float ss[2][4];
#pragma unroll
        for (int ai = 0; ai < 2; ++ai)
#pragma unroll
            for (int m = 0; m < 4; ++m) ss[ai][m] = 0.f;
        int kind = 0;
#pragma unroll
        for (int bj = 0; bj < 2; ++bj) {
            const int rn = u.rn;
            const bool isq = rn >= 8;
            bf16_t* dst = (rn == 0) ? CKV : (rn == 1 || rn == 2) ? DK : (rn == 3 || rn == 4) ? DV : (rn == 5) ? (bj ? SV : SK) : (rn == 6) ? KR : (rn == 7) ? CQ : (rn == 8 || rn == 9) ? DQ : SQ;
            const int ld = (rn == 0 || rn == 7) ? 256 : (rn == 5) ? 128 : (rn == 6) ? 32 : 512;
            const int col = (rn == 5 || rn == 6) ? 0 : (((rn == 2 || rn == 4 || rn == 9 || rn == 11) ? 256 : 0) + 128 * bj);
            kind = (rn == 0 || rn == 7) ? 2 : (rn == 3 || rn == 4) ? 0 : (rn == 5) ? (bj ? 0 : 1) : (rn == 6) ? (bj ? 4 : 3) : 1;
            const float scale = isq ? qscale : 1.f;
            if (kind == 4) continue;
            if (kind == 3) {
                if (wc != 0) continue;
#pragma unroll
                for (int ai = 0; ai < 2; ++ai)
#pragma unroll
                    for (int m = 0; m < 4; ++m) {
                        const int row = row0 + ai * HALF + m * 16;
                        f32x4 x0 = acc[ai][bj][m][0], x1 = acc[ai][bj][m][1];
                        if (lat) {
                            f32x4 o0, o1;
#pragma unroll
                            for (int j = 0; j < 4; ++j) { o0[j] = __shfl_xor(x0[j], 32); o1[j] = __shfl_xor(x1[j], 32); }
                            const int pr = (row >> 6) & 63, pc = row & 63, ib = 4 * (fq & 1);
                            const f32x4 cr = gldf4(TAB + 2048 + pr * 8 + ib), sr = gldf4(TAB + 2560 + pr * 8 + ib);
                            const f32x4 cc = gldf4(TAB + 2048 + pc * 8 + ib), sc = gldf4(TAB + 2560 + pc * 8 + ib);
                            if (fq < 2) { x0 = x0 * cr - o0 * sr; x1 = x1 * cc - o1 * sc; } else { x0 = x0 * cr + o0 * sr; x1 = x1 * cc + o1 * sc; }
                        }
                        u32x2 w0, w1; w0.x = cvt_pk_bf16(x0[0], x0[1]); w0.y = cvt_pk_bf16(x0[2], x0[3]); w1.x = cvt_pk_bf16(x1[0], x1[1]); w1.y = cvt_pk_bf16(x1[2], x1[3]);
                        bf16_t* p = dst + (size_t)row * 32 + 4 * fq; gst8(p, w0.x, w0.y); gst8(p + 16, w1.x, w1.y);
                    }
                continue;
            }
            const bool rope = (kind == 1) && lat;
#pragma unroll
            for (int ai = 0; ai < 2; ++ai)
#pragma unroll
                for (int m = 0; m < 4; ++m) {
                    const int row = row0 + ai * HALF + m * 16;
                    f32x4 x0 = acc[ai][bj][m][0], x1 = acc[ai][bj][m][1];
                    if (kind == 2) { ss[ai][m] += (x0[0] * x0[0] + x0[1] * x0[1]) + (x0[2] * x0[2] + x0[3] * x0[3]) + (x1[0] * x1[0] + x1[1] * x1[1]) + (x1[2] * x1[2] + x1[3] * x1[3]); }
                    if (rope) {
                        const int pos = (wc & 1) ? (row & 63) : ((row >> 6) & 63);
                        const f32x4 c4 = gldf4(TAB + pos * 16 + 4 * fq), s4 = gldf4(TAB + 1024 + pos * 16 + 4 * fq);
                        const f32x4 y0 = x0 * c4 - x1 * s4, y1 = x1 * c4 + x0 * s4; x0 = y0; x1 = y1;
                    }
                    x0 = x0 * scale; x1 = x1 * scale;
                    u32x2 w0, w1; w0.x = cvt_pk_bf16(x0[0], x0[1]); w0.y = cvt_pk_bf16(x0[2], x0[3]); w1.x = cvt_pk_bf16(x1[0], x1[1]); w1.y = cvt_pk_bf16(x1[2], x1[3]);
                    bf16_t* p = dst + (size_t)row * ld + col + 32 * wc + 4 * fq; gst8(p, w0.x, w0.y); gst8(p + 16, w1.x, w1.y);
                }
        }
        if (kind == 2) {
            float* S = (u.rn == 0) ? SSKV : SSQ;
#pragma unroll
            for (int ai = 0; ai < 2; ++ai)
#pragma unroll
                for (int m = 0; m < 4; ++m) {
                    float s = ss[ai][m]; s += __shfl_xor(s, 16); s += __shfl_xor(s, 32);
                    if (fq == 0) *(PG8_GAS float*)(S + (size_t)(row0 + ai * HALF + m * 16) * 4 + wc) = s;
                }
        }
    }
};

struct EpiP2 {
    static constexpr bool PERM = true, AFTER_DRAIN = false;
    bf16_t *MK, *MV, *QN, *QR; const float *SSKV, *SSQ; const float* TAB; float qscale; float eps;
    __device__ __forceinline__ void operator()(const f32x4 (&acc)[2][2][4][2], const Unit& u, int wr, int wc, int fr, int fq) const {
        const bool isq = (u.aux & 0x100) != 0, lat = u.rm < 64;
        const int row0 = u.rm * BM + wr * 64 + fr;
        const float* SS = isq ? SSQ : SSKV;
#pragma unroll
        for (int ai = 0; ai < 2; ++ai)
#pragma unroll
            for (int m = 0; m < 4; ++m) {
                const int row = row0 + ai * HALF + m * 16;
                const f32x4 s4 = gldf4(SS + (size_t)row * 4);
                float rs = rsqrtf(((s4[0] + s4[1]) + (s4[2] + s4[3])) * (1.0f / 256.0f) + eps);
                if (isq) rs *= qscale;
#pragma unroll
                for (int bj = 0; bj < 2; ++bj) {
                    f32x4 x0 = acc[ai][bj][m][0] * rs, x1 = acc[ai][bj][m][1] * rs;
                    bf16_t* p;
                    if (!isq) {
                        const int head = 2 * u.rn + bj;
                        p = ((wc < 2) ? MK : MV) + (size_t)row * 512 + head * 64 + (wc & 1) * 32 + 8 * fq;
                    } else {
                        const int g = u.rn * 8 + bj * 4 + wc, head = g / 3, part = g - head * 3;
                        if (part < 2) p = QN + (size_t)row * 512 + head * 64 + part * 32 + 8 * fq;
                        else {
                            p = QR + (size_t)row * 256 + head * 32 + 8 * fq;
                            if (lat) {
                                f32x4 o0, o1;
#pragma unroll
                                for (int j = 0; j < 4; ++j) { o0[j] = __shfl_xor(x0[j], 16); o1[j] = __shfl_xor(x1[j], 16); }
                                const int pos = (fq & 2) ? (row & 63) : ((row >> 6) & 63);
                                const f32x4 c0 = gldf4(TAB + 2048 + pos * 8), c1 = gldf4(TAB + 2048 + pos * 8 + 4);
                                const f32x4 s0 = gldf4(TAB + 2560 + pos * 8), s1 = gldf4(TAB + 2560 + pos * 8 + 4);
                                if ((fq & 1) == 0) { x0 = x0 * c0 - o0 * s0; x1 = x1 * c1 - o1 * s1; } else { x0 = x0 * c0 + o0 * s0; x1 = x1 * c1 + o1 * s1; }
                            }
                        }
                    }
                    u32x4 w; w.x = cvt_pk_bf16(x0[0], x0[1]); w.y = cvt_pk_bf16(x0[2], x0[3]); w.z = cvt_pk_bf16(x1[0], x1[1]); w.w = cvt_pk_bf16(x1[2], x1[3]);
                    gst16(p, w);
                }
            }
    }
};

#ifndef MK_SIG_PERM
#define MK_SIG_PERM true
#endif
struct EpiSig {
    static constexpr bool PERM = MK_SIG_PERM, AFTER_DRAIN = false;
    bf16_t* G;
    __device__ __forceinline__ void operator()(const f32x4 (&acc)[2][2][4][2], const Unit& u, int wr, int wc, int fr, int fq) const {
        const int row0 = u.rm * BM + wr * 64 + fr;
#pragma unroll
        for (int ai = 0; ai < 2; ++ai)
#pragma unroll
            for (int m = 0; m < 4; ++m)
#pragma unroll
                for (int bj = 0; bj < 2; ++bj) {
                    const f32x4 x0 = acc[ai][bj][m][0], x1 = acc[ai][bj][m][1];
                    u32x4 w; w.x = cvt_pk_bf16(fast_sigmoid(x0[0]), fast_sigmoid(x0[1])); w.y = cvt_pk_bf16(fast_sigmoid(x0[2]), fast_sigmoid(x0[3]));
                    w.z = cvt_pk_bf16(fast_sigmoid(x1[0]), fast_sigmoid(x1[1])); w.w = cvt_pk_bf16(fast_sigmoid(x1[2]), fast_sigmoid(x1[3]));
                    bf16_t* rowp = G + (size_t)(row0 + ai * HALF + m * 16) * 3072 + u.rn * BM + bj * HALF + wc * 32;
#ifdef MK_SIG_ST8
                    if (PERM) { gst8(rowp + 8 * fq, w.x, w.y); gst8(rowp + 8 * fq + 4, w.z, w.w); }
#else
                    if (PERM) gst16(rowp + 8 * fq, w);
#endif
                    else { gst8(rowp + 4 * fq, w.x, w.y); gst8(rowp + 16 + 4 * fq, w.z, w.w); }
                }
    }
};

struct EpiMerge {
    static constexpr bool PERM = true, AFTER_DRAIN = false;
    const bf16_t* G; bf16_t* Mb;
    __device__ __forceinline__ void operator()(const f32x4 (&acc)[2][2][4][2], const Unit& u, int wr, int wc, int fr, int fq) const {
        const int br = u.aux & 0xff;
        const int row0 = u.rm * BM + wr * 64 + fr, col0 = u.rn * BM + wc * 32 + 8 * fq;
#pragma unroll
        for (int ai = 0; ai < 2; ++ai) {
            u32x4 g[4][2], mo[4][2];
#pragma unroll
            for (int m = 0; m < 4; ++m)
#pragma unroll
                for (int bj = 0; bj < 2; ++bj) {
                    const size_t row = (size_t)(row0 + ai * HALF + m * 16); const int col = col0 + bj * HALF;
                    g[m][bj] = gld16(G + row * 3072 + br * 1024 + col);
                    mo[m][bj] = (u32x4){0u, 0u, 0u, 0u}; if (br != 0) mo[m][bj] = gld16(Mb + row * 1024 + col);
                }
#pragma unroll
            for (int m = 0; m < 4; ++m)
#pragma unroll
                for (int bj = 0; bj < 2; ++bj) {
                    const size_t row = (size_t)(row0 + ai * HALF + m * 16); const int col = col0 + bj * HALF;
                    const f32x4 x0 = acc[ai][bj][m][0], x1 = acc[ai][bj][m][1]; const u32x4 gg = g[m][bj], mm = mo[m][bj];
                    u32x4 w;
                    w.x = cvt_pk_bf16(bf_lo(mm.x) + bf_lo(gg.x) * x0[0], bf_hi(mm.x) + bf_hi(gg.x) * x0[1]);
                    w.y = cvt_pk_bf16(bf_lo(mm.y) + bf_lo(gg.y) * x0[2], bf_hi(mm.y) + bf_hi(gg.y) * x0[3]);
                    w.z = cvt_pk_bf16(bf_lo(mm.z) + bf_lo(gg.z) * x1[0], bf_hi(mm.z) + bf_hi(gg.z) * x1[1]);
                    w.w = cvt_pk_bf16(bf_lo(mm.w) + bf_lo(gg.w) * x1[2], bf_hi(mm.w) + bf_hi(gg.w) * x1[3]);
                    gst16(Mb + row * 1024 + col, w);
                }
        }
    }
};

struct EpiF32 {
    static constexpr bool PERM = true, AFTER_DRAIN = false;
    bf16_t* Y; int ldc;
    __device__ __forceinline__ void operator()(const f32x4 (&acc)[2][2][4][2], const Unit& u, int wr, int wc, int fr, int fq) const {
        const int row0 = u.rm * BM + wr * 64 + fr, col0 = u.rn * BM + wc * 32 + 8 * fq;
#pragma unroll
        for (int ai = 0; ai < 2; ++ai)
#pragma unroll
            for (int m = 0; m < 4; ++m)
#pragma unroll
                for (int bj = 0; bj < 2; ++bj) {
                    const f32x4 x0 = acc[ai][bj][m][0], x1 = acc[ai][bj][m][1];
                    u32x4 w; w.x = cvt_pk_bf16(x0[0], x0[1]); w.y = cvt_pk_bf16(x0[2], x0[3]); w.z = cvt_pk_bf16(x1[0], x1[1]); w.w = cvt_pk_bf16(x1[2], x1[3]);
                    gst16(Y + (size_t)(row0 + ai * HALF + m * 16) * ldc + col0 + bj * HALF, w);
                }
    }
};

struct EpiSwiglu {
    static constexpr bool PERM = true, AFTER_DRAIN = false;
    bf16_t* ACT;
    __device__ __forceinline__ void operator()(const f32x4 (&acc)[2][2][4][2], const Unit& u, int wr, int wc, int fr, int fq) const {
        const int row0 = u.rm * BM + wr * 64 + fr, col0 = u.rn * HALF + wc * 32 + 8 * fq;
#pragma unroll
        for (int ai = 0; ai < 2; ++ai)
#pragma unroll
            for (int m = 0; m < 4; ++m) {
                const f32x4 g0 = acc[ai][0][m][0], g1 = acc[ai][0][m][1], u0 = acc[ai][1][m][0], u1 = acc[ai][1][m][1];
                u32x4 w;
                w.x = cvt_pk_bf16(g0[0] * fast_sigmoid(g0[0]) * u0[0], g0[1] * fast_sigmoid(g0[1]) * u0[1]);
                w.y = cvt_pk_bf16(g0[2] * fast_sigmoid(g0[2]) * u0[2], g0[3] * fast_sigmoid(g0[3]) * u0[3]);
                w.z = cvt_pk_bf16(g1[0] * fast_sigmoid(g1[0]) * u1[0], g1[1] * fast_sigmoid(g1[1]) * u1[1]);
                w.w = cvt_pk_bf16(g1[2] * fast_sigmoid(g1[2]) * u1[2], g1[3] * fast_sigmoid(g1[3]) * u1[3]);
                gst16(ACT + (size_t)(row0 + ai * HALF + m * 16) * 2816 + col0, w);
            }
    }
};

template <class Epi, class Sched, bool ALIGN_EPI = false, bool SP2 = false>
__device__ __forceinline__ void gemm_phase(PG8_LAS unsigned char* lds, const Gemm g, const Sched& S, const Epi& E, const int wave_in, const int lane_in) {
    const int wid = wave_in, lane = lane_in, tid = wid * 64 + lane, wr = wid >> 2, wc = wid & 3, fr = lane & 15, fq = lane >> 4;
    const int K = g.K, nt = K / BK;
    unsigned voffA[2], voffB[2];
#pragma unroll
    for (int i = 0; i < 2; ++i) { int R, C; stage_rc(tid * 16 + i * 8192, R, C); const int Rb = Epi::PERM ? ((R & ~31) + perm32(R & 31)) : R;
        voffA[i] = (unsigned)(R * K + C) * 2u; voffB[i] = (unsigned)(Rb * K + C) * 2u; }
    const size_t kstep = (size_t)(BK * 2);
    const size_t hstep = (size_t)HALF * K * 2;
    const size_t tstep = 2 * hstep;
    const unsigned ldsw = (unsigned)wid * 1024u;
    const int aoff = lds_byte(wr * 64 + fr, fq * 8), boff = lds_byte(wc * 32 + fr, fq * 8);
#define PG8_SA(b, h) (((b) * 2 + (h)) * HTB)
#define PG8_SB(b, h) ((4 + (b) * 2 + (h)) * HTB)
#define PG8_STAGE(bufoff, gbase, voff) do { _Pragma("unroll") for (int _i = 0; _i < 2; ++_i) \
        __builtin_amdgcn_global_load_lds((const unsigned*)((const char*)(gbase) + (voff)[_i]), (PG8_LAS unsigned*)(lds + (bufoff) + ldsw + _i * 8192), 16, 0, 0); } while (0)
#define PG8_LDA(dst, b, h) do { _Pragma("unroll") for (int m = 0; m < 4; ++m) _Pragma("unroll") for (int k = 0; k < 2; ++k) dst[m][k] = *(const PG8_LAS bf16x8*)(lds + PG8_SA(b, h) + aoff + m * 2048 + k * 1024); } while (0)
#define PG8_LDB(dst, b, h) do { _Pragma("unroll") for (int n = 0; n < 2; ++n) _Pragma("unroll") for (int k = 0; k < 2; ++k) dst[n][k] = *(const PG8_LAS bf16x8*)(lds + PG8_SB(b, h) + boff + n * 2048 + k * 1024); } while (0)
#define PG8_MMA(ai, bj, At, Bt) do { __builtin_amdgcn_s_setprio(1); _Pragma("unroll") for (int m = 0; m < 4; ++m) _Pragma("unroll") for (int n = 0; n < 2; ++n) _Pragma("unroll") for (int k = 0; k < 2; ++k) \
        acc[ai][bj][m][n] = __builtin_amdgcn_mfma_f32_16x16x32_bf16(Bt[n][k], At[m][k], acc[ai][bj][m][n], 0, 0, 0); __builtin_amdgcn_s_setprio(0); } while (0)
#define PG8_WAIT_V(n) asm volatile("s_waitcnt vmcnt(" #n ")" ::: "memory")
#define PG8_WAIT_L(n) asm volatile("s_waitcnt lgkmcnt(" #n ")" ::: "memory")
#define PG8_BAR __builtin_amdgcn_s_barrier()
#define PG8_SCHED __builtin_amdgcn_sched_barrier(0)
    Unit cur, nxt; int ui = 0;
    if (!S.next(0, cur)) return;
    f32x4 acc[2][2][4][2];
#pragma unroll
    for (int a = 0; a < 2; ++a)
#pragma unroll
        for (int b = 0; b < 2; ++b)
#pragma unroll
            for (int m = 0; m < 4; ++m)
#pragma unroll
                for (int n = 0; n < 2; ++n) acc[a][b][m][n] = (f32x4){0.f, 0.f, 0.f, 0.f};
    bf16x8 At[4][2], B0[2][2], B1[2][2];
    const char* cA = (const char*)g.A + (size_t)cur.pm * tstep; const char* cB = (const char*)g.Bt + (size_t)cur.pn * tstep;
    S.a_ready(cur);
    if constexpr (SP2) {
        PG8_STAGE(PG8_SB(0, 0), cB, voffB); PG8_STAGE(PG8_SB(0, 1), cB + hstep, voffB); PG8_STAGE(PG8_SA(0, 0), cA, voffA); PG8_STAGE(PG8_SA(0, 1), cA + hstep, voffA);
        if (wr == 1) PG8_BAR;
        PG8_WAIT_V(2); PG8_BAR;
        PG8_STAGE(PG8_SB(1, 0), cB + kstep, voffB); PG8_STAGE(PG8_SA(1, 0), cA + kstep, voffA); PG8_STAGE(PG8_SB(1, 1), cB + hstep + kstep, voffB);
        PG8_WAIT_V(6); PG8_BAR;
    } else {
        PG8_STAGE(PG8_SB(0, 0), cB, voffB); PG8_STAGE(PG8_SA(0, 0), cA, voffA); PG8_STAGE(PG8_SB(0, 1), cB + hstep, voffB); PG8_STAGE(PG8_SA(0, 1), cA + hstep, voffA);
        if (wr == 1) PG8_BAR;
        PG8_WAIT_V(4); PG8_BAR;
        PG8_STAGE(PG8_SB(1, 0), cB + kstep, voffB); PG8_STAGE(PG8_SA(1, 0), cA + kstep, voffA); PG8_STAGE(PG8_SB(1, 1), cB + hstep + kstep, voffB);
        PG8_WAIT_V(6); PG8_BAR;
    }
    for (;;) {
        const bool has_next = S.next(ui + 1, nxt);
        const char* nA = has_next ? (const char*)g.A + (size_t)nxt.pm * tstep : cA; const char* nB = has_next ? (const char*)g.Bt + (size_t)nxt.pn * tstep : cB;
        for (int t = 0; t < nt; t += 2) {
            const bool last = (t == nt - 2);
            const char* a1 = cA + (size_t)(t + 1) * kstep;
            const char* a2 = last ? nA : cA + (size_t)(t + 2) * kstep; const char* b2 = last ? nB : cB + (size_t)(t + 2) * kstep;
            const char* a3 = a2 + kstep; const char* b3 = b2 + kstep;
            if (last && has_next) S.a_ready(nxt);
            if constexpr (SP2) {
            PG8_LDB(B0, 0, 0); PG8_LDB(B1, 0, 1); PG8_SCHED; PG8_LDA(At, 0, 0); PG8_STAGE(PG8_SA(1, 1), a1 + hstep, voffA);
            PG8_WAIT_V(8); PG8_WAIT_L(0); PG8_BAR; PG8_MMA(0, 0, At, B0); PG8_MMA(0, 1, At, B1); PG8_BAR; PG8_SCHED;
            PG8_LDA(At, 0, 1); PG8_STAGE(PG8_SB(0, 0), b2, voffB); PG8_STAGE(PG8_SB(0, 1), b2 + hstep, voffB); PG8_STAGE(PG8_SA(0, 0), a2, voffA);
            PG8_WAIT_V(8); PG8_WAIT_L(0); PG8_BAR; PG8_MMA(1, 0, At, B0); PG8_MMA(1, 1, At, B1); PG8_BAR; PG8_SCHED;
            PG8_LDB(B0, 1, 0); PG8_LDB(B1, 1, 1); PG8_SCHED; PG8_LDA(At, 1, 0); PG8_STAGE(PG8_SA(0, 1), a2 + hstep, voffA);
            PG8_WAIT_V(8); PG8_WAIT_L(0); PG8_BAR; PG8_MMA(0, 0, At, B0); PG8_MMA(0, 1, At, B1); PG8_BAR; PG8_SCHED;
            PG8_LDA(At, 1, 1); PG8_STAGE(PG8_SB(1, 0), b3, voffB); PG8_STAGE(PG8_SB(1, 1), b3 + hstep, voffB); PG8_STAGE(PG8_SA(1, 0), a3, voffA);
            PG8_WAIT_V(8); PG8_WAIT_L(0); PG8_BAR; PG8_MMA(1, 0, At, B0); PG8_MMA(1, 1, At, B1); PG8_BAR; PG8_SCHED;
            } else {
            PG8_LDB(B0, 0, 0); PG8_SCHED; PG8_LDA(At, 0, 0); PG8_STAGE(PG8_SA(1, 1), a1 + hstep, voffA);
            PG8_WAIT_L(8); PG8_BAR; PG8_WAIT_L(0); PG8_MMA(0, 0, At, B0); PG8_BAR; PG8_SCHED;
            PG8_LDB(B1, 0, 1); PG8_STAGE(PG8_SB(0, 0), b2, voffB);
            PG8_BAR; PG8_WAIT_L(0); PG8_MMA(0, 1, At, B1); PG8_BAR;
            PG8_LDA(At, 0, 1); PG8_STAGE(PG8_SA(0, 0), a2, voffA);
            PG8_BAR; PG8_WAIT_L(0); PG8_MMA(1, 0, At, B0); PG8_BAR; PG8_SCHED;
            PG8_STAGE(PG8_SB(0, 1), b2 + hstep, voffB);
            PG8_WAIT_V(6); PG8_BAR; PG8_MMA(1, 1, At, B1); PG8_BAR;
            PG8_LDB(B0, 1, 0); PG8_SCHED; PG8_LDA(At, 1, 0); PG8_STAGE(PG8_SA(0, 1), a2 + hstep, voffA);
            PG8_WAIT_L(8); PG8_BAR; PG8_WAIT_L(0); PG8_MMA(0, 0, At, B0); PG8_BAR; PG8_SCHED;
            PG8_LDB(B1, 1, 1); PG8_STAGE(PG8_SB(1, 0), b3, voffB);
            PG8_BAR; PG8_WAIT_L(0); PG8_MMA(0, 1, At, B1); PG8_BAR;
            PG8_LDA(At, 1, 1); PG8_STAGE(PG8_SA(1, 0), a3, voffA);
            PG8_BAR; PG8_WAIT_L(0); PG8_MMA(1, 0, At, B0); PG8_BAR; PG8_SCHED;
            PG8_STAGE(PG8_SB(1, 1), b3 + hstep, voffB);
            PG8_WAIT_V(6); PG8_BAR; PG8_MMA(1, 1, At, B1); PG8_BAR;
            }
        }
        if constexpr (ALIGN_EPI) { if (wr == 0) PG8_BAR; }
        if constexpr (!Epi::AFTER_DRAIN) {
            int ln_; asm volatile("v_mbcnt_lo_u32_b32 %0, -1, 0\n\tv_mbcnt_hi_u32_b32 %0, -1, %0" : "=v"(ln_));
            E(acc, cur, wr, wc, ln_ & 15, ln_ >> 4); S.done(cur); }
        if (!has_next) break;
#pragma unroll
        for (int a = 0; a < 2; ++a)
#pragma unroll
            for (int b = 0; b < 2; ++b)
#pragma unroll
                for (int m = 0; m < 4; ++m)
#pragma unroll
                    for (int n = 0; n < 2; ++n) acc[a][b][m][n] = (f32x4){0.f, 0.f, 0.f, 0.f};
        cur = nxt; cA = nA; cB = nB; ++ui;
        if constexpr (ALIGN_EPI) { if (wr == 1) PG8_BAR; }
    }
    PG8_WAIT_V(0);
    if constexpr (!ALIGN_EPI) { if (wr == 0) PG8_BAR; }
    PG8_BAR;
    if constexpr (Epi::AFTER_DRAIN) { E.fused(acc, cur, wr, wc, fr, fq, lds, wid, lane); S.done(cur); }
#undef PG8_SA
#undef PG8_SB
#undef PG8_STAGE
#undef PG8_LDA
#undef PG8_LDB
#undef PG8_MMA
#undef PG8_WAIT_V
#undef PG8_WAIT_L
#undef PG8_BAR
#undef PG8_SCHED
}
}

namespace att {
#define ALAS __attribute__((address_space(3)))
#define AGAS __attribute__((address_space(1)))
typedef unsigned short bf16_t;
typedef short bf16x8 __attribute__((ext_vector_type(8)));
typedef short s16x4 __attribute__((ext_vector_type(4)));
typedef float f32x16 __attribute__((ext_vector_type(16)));
typedef unsigned u32x4 __attribute__((ext_vector_type(4)));
#ifndef ATT_PIPE
#define ATT_PIPE 1
#endif
#ifndef ATT_PROBE
#define ATT_PROBE 0
#endif
#ifndef ATT_PRIO
#define ATT_PRIO 1
#endif
#ifndef ATT_STAGGER
#define ATT_STAGGER 1
#endif
#ifndef ATT_NEGM
#define ATT_NEGM 1
#endif
constexpr int SLOT = 24576, NSLOT = 4, WSF_OFF = NSLOT * SLOT, LDS_NEED = WSF_OFF + 2048;
constexpr float THR = 6.0f;
__device__ __forceinline__ int crow(int r, int hi) { return (r & 3) + 8 * (r >> 2) + 4 * hi; }
typedef float f32x2_t __attribute__((ext_vector_type(2))); typedef __bf16 bf16x2_t __attribute__((ext_vector_type(2)));
__device__ __forceinline__ unsigned cvtpk(float lo, float hi) { f32x2_t v = {lo, hi}; bf16x2_t b = __builtin_convertvector(v, bf16x2_t); return __builtin_bit_cast(unsigned, b); }
__device__ __forceinline__ s16x4 vtr(const ALAS unsigned char* p) { typedef short v4i16_t __attribute__((ext_vector_type(4))); return __builtin_bit_cast(s16x4, __builtin_amdgcn_ds_read_tr16_b64_v4i16((ALAS v4i16_t*)p)); }

__device__ __forceinline__ float max3f(float x, float y, float z) { float r; asm("v_max3_f32 %0, %1, %2, %3" : "=v"(r) : "v"(x), "v"(y), "v"(z)); return r; }
__device__ __forceinline__ void glds16(const void* gsrc, unsigned lds_dst) { unsigned keep;
    asm volatile("s_mov_b32 %0, m0\n\ts_mov_b32 m0, %2\n\ts_nop 0\n\tglobal_load_lds_dwordx4 %1, off\n\ts_mov_b32 m0, %0" : "=&s"(keep) : "v"(gsrc), "s"(lds_dst) : "memory"); }
#define ATT_WAIT_BAR(N) asm volatile("s_waitcnt vmcnt(" #N ") lgkmcnt(0)\n\ts_barrier" ::: "memory")

struct Src {
    const bf16_t* k1; int ldk1;
    const bf16_t* k2; int ldk2;
    const bf16_t* v;  int ldv;
    int ctx_row0;
    int lat_row0, nlat;
    int probe;
};

template <int DQK, int DV, int MODE>
__device__ __forceinline__ void attn_pass(ALAS unsigned char* lds, const Src& S, const bf16_t* qp, int ldq, const bf16_t* qp2, int ldq2, float sink2, int tq0  , int slat0  , f32x16 (&o)[DV / 32], int wid, int lane) {
    constexpr int NKS = DQK / 16, NDB = DV / 32, NKP = DQK / 8, NVP = NDB * 4;
    constexpr bool NEGM = ATT_NEGM && (DV < 128);
    const int r32 = lane & 31, hi = lane >> 5;
    const bool late = ATT_STAGGER && (wid >= 4);
    ALAS float* wsf = (ALAS float*)(lds + WSF_OFF) + wid * 64;
    const int NT = 4 + S.nlat;
    bf16x8 qf[NKS];
#pragma unroll
    for (int d0 = 0; d0 < NKS; ++d0) {
        if (d0 < 4) qf[d0] = *(const AGAS bf16x8*)(qp + (size_t)(wid * 32 + r32) * ldq + d0 * 16 + hi * 8);
        else qf[d0] = *(const AGAS bf16x8*)(qp2 + (size_t)(wid * 32 + r32) * ldq2 + (d0 - 4) * 16 + hi * 8);
    }
    constexpr int KB = DQK * 128, NKI = (NKP + 7) / 8, NVI = NVP / 8, NPER = NKI + NVI;
    static_assert(NPER == 2 || NPER == 3, "pieces per wave per tile");
    const unsigned lds0 = (unsigned)(uintptr_t)lds;
    const char* psrc[NPER]; unsigned pdst[NPER]; long pstep[NPER];
    int tn = 0;
    auto point_at = [&](int t) {
        const int krow = (t < 4) ? (S.ctx_row0 + 64 * t) : (S.lat_row0 + 64 * (t - 4));
#pragma unroll
        for (int i = 0; i < NKI; ++i) {
            int c = wid + 8 * i; if (c >= NKP) c = wid;
            psrc[i] = (const char*)((c < 8) ? (S.k1 + (size_t)(krow + lane) * S.ldk1 + c * 8) : (S.k2 + (size_t)(krow + lane) * S.ldk2 + (c - 8) * 8));
            pstep[i] = (c < 8) ? 128L * S.ldk1 : 128L * S.ldk2; pdst[i] = (unsigned)(c * 1024);
        }
#pragma unroll
        for (int i = 0; i < NVI; ++i) {
            const int p = wid + 8 * i, db = p >> 2, ks = p & 3;
            psrc[NKI + i] = (const char*)(S.v + (size_t)(krow + 16 * ks + (lane >> 2)) * S.ldv + db * 32 + (lane & 3) * 8);
            pstep[NKI + i] = 128L * S.ldv; pdst[NKI + i] = (unsigned)(KB + p * 1024);
        }
    };
    unsigned dslot = lds0;
    auto issue_next = [&]() {
        if (tn == 4) point_at(4);
        unsigned keep;
        const unsigned d0 = (unsigned)__builtin_amdgcn_readfirstlane(dslot + pdst[0]), d1 = (unsigned)__builtin_amdgcn_readfirstlane(dslot + pdst[1]);
        if constexpr (NPER == 2) {
            asm volatile("s_mov_b32 %0, m0\n\ts_mov_b32 m0, %3\n\ts_nop 0\n\tglobal_load_lds_dwordx4 %1, off\n\ts_mov_b32 m0, %4\n\ts_nop 0\n\tglobal_load_lds_dwordx4 %2, off\n\ts_mov_b32 m0, %0"
                         : "=&s"(keep) : "v"(psrc[0]), "v"(psrc[1]), "s"(d0), "s"(d1) : "memory");
        } else {
            const unsigned d2 = (unsigned)__builtin_amdgcn_readfirstlane(dslot + pdst[NPER - 1]);
            asm volatile("s_mov_b32 %0, m0\n\ts_mov_b32 m0, %4\n\ts_nop 0\n\tglobal_load_lds_dwordx4 %1, off\n\ts_mov_b32 m0, %5\n\ts_nop 0\n\tglobal_load_lds_dwordx4 %2, off\n\ts_mov_b32 m0, %6\n\ts_nop 0\n\tglobal_load_lds_dwordx4 %3, off\n\ts_mov_b32 m0, %0"
                         : "=&s"(keep) : "v"(psrc[0]), "v"(psrc[1]), "v"(psrc[NPER - 1]), "s"(d0), "s"(d1), "s"(d2) : "memory");
        }
#pragma unroll
        for (int i = 0; i < NPER; ++i) psrc[i] += pstep[i];
        dslot = (dslot == lds0 + (NSLOT - 1) * SLOT) ? lds0 : dslot + SLOT; ++tn;
    };
    if constexpr (DV < 128) point_at(0);
    auto issue_t = [&](int t) {
        const int krow = (t < 4) ? (S.ctx_row0 + 64 * t) : (S.lat_row0 + 64 * (t - 4));
        const unsigned sbx = lds0 + (unsigned)((t % NSLOT) * SLOT);
#pragma unroll
        for (int i = 0; i < NKI; ++i) {
            int c = wid + 8 * i; if (c >= NKP) c = wid;
            const bf16_t* src = (c < 8) ? (S.k1 + (size_t)(krow + lane) * S.ldk1 + c * 8) : (S.k2 + (size_t)(krow + lane) * S.ldk2 + (c - 8) * 8);
            glds16(src, (unsigned)__builtin_amdgcn_readfirstlane(sbx + c * 1024));
        }
#pragma unroll
        for (int i = 0; i < NVI; ++i) {
            const int p = wid + 8 * i, db = p >> 2, ks = p & 3;
            const bf16_t* src = S.v + (size_t)(krow + 16 * ks + (lane >> 2)) * S.ldv + db * 32 + (lane & 3) * 8;
            glds16(src, (unsigned)__builtin_amdgcn_readfirstlane(sbx + KB + p * 1024));
        }
    };
    constexpr bool PERSIST = (DV < 128);
    float mrun = (MODE == 1) ? sink2 : 0.0f;
    float lrun = (MODE == 1 && hi == 0) ? 1.0f : 0.0f;
#pragma unroll
    for (int db = 0; db < NDB; ++db)
#pragma unroll
        for (int r = 0; r < 16; ++r) o[db][r] = 0.f;
    f32x16 negm;
    if constexpr (NEGM) {
#pragma unroll
        for (int r = 0; r < 16; ++r) negm[r] = -mrun;
    }
    const int tw0 = tq0 + wid * 32;
    const int vp = ((lane >> 4) & 1) * 32 + (lane & 3) * 8 + (4 * hi + ((lane & 15) >> 2)) * 64;
    auto pv = [&](const u32x4 (&pwv)[4], const ALAS unsigned char* sbv) {
        constexpr int NF = NDB * 4, PDV = (DV < 128) ? 3 : 2;
        const ALAS unsigned char* vb = sbv + KB + vp;
        s16x4 vlo[PDV], vhi[PDV];
#pragma unroll
        for (int i = 0; i < PDV; ++i) { vlo[i] = vtr(vb + i * 1024); vhi[i] = vtr(vb + i * 1024 + 512); }
        __builtin_amdgcn_sched_barrier(0);
        __builtin_amdgcn_s_setprio(ATT_PRIO);
#pragma unroll
        for (int i = 0; i < NF; ++i) {
            const s16x4 lo = vlo[i % PDV], hh = vhi[i % PDV];
            if (i + PDV < NF) { vlo[i % PDV] = vtr(vb + (i + PDV) * 1024); vhi[i % PDV] = vtr(vb + (i + PDV) * 1024 + 512); }
            const bf16x8 vf = (bf16x8){lo[0], lo[1], lo[2], lo[3], hh[0], hh[1], hh[2], hh[3]};
            o[i >> 2] = __builtin_amdgcn_mfma_f32_32x32x16_bf16(__builtin_bit_cast(bf16x8, pwv[i & 3]), vf, o[i >> 2], 0, 0, 0);
            __builtin_amdgcn_sched_barrier(0);
        }
        __builtin_amdgcn_s_setprio(0);
    };
    u32x4 pw[4];
    const ALAS unsigned char* sb_pend = lds; bool pend = false;
    if (!(S.probe & 2)) { if constexpr (PERSIST) { issue_next(); issue_next(); } else { issue_t(0); issue_t(1); } }
    int slot = 0;
    for (int t = 0; t < NT; ++t) {
        if (!(S.probe & 1)) { if (t + 1 < NT) { if constexpr (NPER == 2) ATT_WAIT_BAR(2); else ATT_WAIT_BAR(3); } else ATT_WAIT_BAR(0); }
        if (t + 2 < NT && !(S.probe & 2)) { if constexpr (PERSIST) issue_next(); else issue_t(t + 2); }
        const ALAS unsigned char* sb = lds + slot * SLOT;
        slot = (slot == NSLOT - 1) ? 0 : slot + 1;
        bool partial = false, active = true;
        if (MODE == 1 && t >= 4) {
            const int sb0 = slat0 + 64 * (t - 4);
            active = !(sb0 > tw0 + 31 + 128 || sb0 + 63 < tw0 - 128);
            partial = (tw0 + 31 - sb0 > 128) || (sb0 + 63 - tw0 > 128);
        }
        constexpr bool PV_MID = (DV < 128) && (MODE == 0);
        if (!PV_MID && pend) { pv(pw, sb_pend); pend = false; }
        if (!active) { if (pend) { pv(pw, sb_pend); pend = false; } continue; }
        f32x16 p0, p1;
        {
            constexpr int NF = 2 * NKS, PDK = (DV < 128) ? 4 : 2;
            const ALAS unsigned char* kb = sb + hi * 1024 + r32 * 16;
            bf16x8 kbuf[PDK];
#pragma unroll
            for (int i = 0; i < PDK; ++i) kbuf[i] = *(const ALAS bf16x8*)(kb + (i >> 1) * 2048 + (i & 1) * 512);
            __builtin_amdgcn_sched_barrier(0);
            __builtin_amdgcn_s_setprio(ATT_PRIO);
#pragma unroll
            for (int i = 0; i < NF; ++i) {
                const bf16x8 kf = kbuf[i % PDK];
                if (i + PDK < NF) kbuf[i % PDK] = *(const ALAS bf16x8*)(kb + ((i + PDK) >> 1) * 2048 + ((i + PDK) & 1) * 512);
                if (i == 0) { if constexpr (NEGM) p0 = __builtin_amdgcn_mfma_f32_32x32x16_bf16(kf, qf[0], negm, 0, 0, 0); else p0 = __builtin_amdgcn_mfma_f32_32x32x16_bf16(kf, qf[0], (f32x16){}, 0, 0, 0); }
                else if (i == 1) { if constexpr (NEGM) p1 = __builtin_amdgcn_mfma_f32_32x32x16_bf16(kf, qf[0], negm, 0, 0, 0); else p1 = __builtin_amdgcn_mfma_f32_32x32x16_bf16(kf, qf[0], (f32x16){}, 0, 0, 0); }
                else if (i & 1) p1 = __builtin_amdgcn_mfma_f32_32x32x16_bf16(kf, qf[i >> 1], p1, 0, 0, 0);
                else p0 = __builtin_amdgcn_mfma_f32_32x32x16_bf16(kf, qf[i >> 1], p0, 0, 0, 0);
                __builtin_amdgcn_sched_barrier(0);
            }
            __builtin_amdgcn_s_setprio(0);
        }
        if (PV_MID && pend) { pv(pw, sb_pend); pend = false; }
        if (MODE == 1 && partial) {
            const int sb0 = slat0 + 64 * (t - 4), tq = tw0 + r32;
#pragma unroll
            for (int r = 0; r < 16; ++r) {
                const int s0 = sb0 + crow(r, hi), d0 = tq - s0, d1 = d0 - 32;
                if (d0 > 128 || d0 < -128) p0[r] = -INFINITY;
                if (d1 > 128 || d1 < -128) p1[r] = -INFINITY;
            }
        }
        asm volatile("s_nop 15\n\ts_nop 7" : "+v"(p0), "+v"(p1));
        float rm;
        { float xa = max3f(p0[0], p0[1], p1[0]), xb = max3f(p0[2], p0[3], p1[1]); xa = max3f(xa, p1[2], p1[3]);
#pragma unroll
          for (int r = 4; r < 16; r += 4) { xa = max3f(xa, p0[r], p0[r + 1]); xb = max3f(xb, p0[r + 2], p0[r + 3]); xa = max3f(xa, p1[r], p1[r + 1]); xb = max3f(xb, p1[r + 2], p1[r + 3]); }
          rm = fmaxf(xa, xb); }
        { auto rr = __builtin_amdgcn_permlane32_swap(__float_as_uint(rm), __float_as_uint(rm), false, false); rm = fmaxf(__uint_as_float(rr[0]), __uint_as_float(rr[1])); }
        if constexpr (!NEGM) rm -= mrun;
        if (__any(rm > THR)) {
            const float dl = fmaxf(rm, 0.f), al = __builtin_amdgcn_exp2f(-dl);
            mrun += dl; lrun *= al;
            if constexpr (NEGM) {
#pragma unroll
                for (int r = 0; r < 16; ++r) { p0[r] -= dl; p1[r] -= dl; negm[r] = -mrun; }
            }
            if (hi == 0) wsf[r32] = al;
#pragma unroll
            for (int r = 0; r < 16; ++r) { const float a = wsf[crow(r, hi)];
#pragma unroll
                for (int db = 0; db < NDB; ++db) o[db][r] *= a; }
        }
        __builtin_amdgcn_sched_barrier(0);
        float sum = 0.f;
#pragma unroll
        for (int r = 0; r < 16; ++r) {
            if constexpr (NEGM) { p0[r] = __builtin_amdgcn_exp2f(p0[r]); p1[r] = __builtin_amdgcn_exp2f(p1[r]); }
            else { p0[r] = __builtin_amdgcn_exp2f(p0[r] - mrun); p1[r] = __builtin_amdgcn_exp2f(p1[r] - mrun); }
            sum += p0[r] + p1[r]; }
        lrun += sum;
#pragma unroll
        for (int w = 0; w < 4; ++w) { pw[0][w] = cvtpk(p0[2 * w], p0[2 * w + 1]); pw[1][w] = cvtpk(p0[8 + 2 * w], p0[8 + 2 * w + 1]); pw[2][w] = cvtpk(p1[2 * w], p1[2 * w + 1]); pw[3][w] = cvtpk(p1[8 + 2 * w], p1[8 + 2 * w + 1]); }
        __builtin_amdgcn_sched_barrier(0);
        if (late) { pend = true; sb_pend = sb; } else pv(pw, sb);
    }
    if (pend) pv(pw, sb_pend);
    { auto rr = __builtin_amdgcn_permlane32_swap(__float_as_uint(lrun), __float_as_uint(lrun), false, false); lrun = __uint_as_float(rr[0]) + __uint_as_float(rr[1]); }
    if (hi == 0) wsf[32 + r32] = lrun;
    ATT_WAIT_BAR(0);
}

#define ATT_PIN(x) asm volatile("" : "+v"(x))
template <int DQK, int DV, int PR>
__device__ __forceinline__ void attn_pass2(ALAS unsigned char* lds, const Src& S, const bf16_t* qp, int ldq, const bf16_t* qp2, int ldq2, f32x16 (&o)[DV / 32], int wid, int lane) {
    constexpr int NKS = DQK / 16, NDB = DV / 32, NKP = DQK / 8, NVP = NDB * 4, NQ = 2 * NKS, NPV = NDB * 4;
    constexpr int KB = DQK * 128, NKI = (NKP + 7) / 8, NVI = NVP / 8, NPER = NKI + NVI;
    const int r32 = lane & 31, hi = lane >> 5;
    ALAS float* wsf = (ALAS float*)(lds + WSF_OFF) + wid * 64;
    const int NT = 4 + S.nlat;
    bf16x8 qf[NKS];
#pragma unroll
    for (int d0 = 0; d0 < NKS; ++d0) {
        if (d0 < 4) qf[d0] = *(const AGAS bf16x8*)(qp + (size_t)(wid * 32 + r32) * ldq + d0 * 16 + hi * 8);
        else qf[d0] = *(const AGAS bf16x8*)(qp2 + (size_t)(wid * 32 + r32) * ldq2 + (d0 - 4) * 16 + hi * 8);
    }
    const unsigned lds0 = (unsigned)(uintptr_t)lds;
    auto issue_t = [&](int t) {
        const int krow = (t < 4) ? (S.ctx_row0 + 64 * t) : (S.lat_row0 + 64 * (t - 4));
        const unsigned sbx = lds0 + (unsigned)((t % NSLOT) * SLOT);
#pragma unroll
        for (int i = 0; i < NKI; ++i) {
            int c = wid + 8 * i; if (c >= NKP) c = wid;
            const bf16_t* src = (c < 8) ? (S.k1 + (size_t)(krow + lane) * S.ldk1 + c * 8) : (S.k2 + (size_t)(krow + lane) * S.ldk2 + (c - 8) * 8);
            glds16(src, (unsigned)__builtin_amdgcn_readfirstlane(sbx + c * 1024));
        }
#pragma unroll
        for (int i = 0; i < NVI; ++i) {
            const int p = wid + 8 * i, db = p >> 2, ks = p & 3;
            const bf16_t* src = S.v + (size_t)(krow + 16 * ks + (lane >> 2)) * S.ldv + db * 32 + (lane & 3) * 8;
            glds16(src, (unsigned)__builtin_amdgcn_readfirstlane(sbx + KB + p * 1024));
        }
    };
    float mrun = 0.f, lrun = 0.f;
    f32x16 negm;
#pragma unroll
    for (int r = 0; r < 16; ++r) negm[r] = 0.f;
#pragma unroll
    for (int db = 0; db < NDB; ++db)
#pragma unroll
        for (int r = 0; r < 16; ++r) o[db][r] = 0.f;
    const int vp = ((lane >> 4) & 1) * 32 + (lane & 3) * 8 + (4 * hi + ((lane & 15) >> 2)) * 64;
    u32x4 pw[4];
    constexpr int PDK = 3;
    bf16x8 kbuf[PDK];
#define ATT_KRD(kbs, i) (*(const ALAS bf16x8*)((kbs) + ((i) >> 1) * 2048 + ((i) & 1) * 512))
#define ATT_QK(P0, P1, kbs, i) do { const bf16x8 kf_ = kbuf[(i) % PDK]; if ((i) + PDK < NQ) kbuf[(i) % PDK] = ATT_KRD(kbs, (i) + PDK); \
        if ((i) == 0) P0 = __builtin_amdgcn_mfma_f32_32x32x16_bf16(kf_, qf[0], negm, 0, 0, 0); else if ((i) == 1) P1 = __builtin_amdgcn_mfma_f32_32x32x16_bf16(kf_, qf[0], negm, 0, 0, 0); \
        else if ((i) & 1) P1 = __builtin_amdgcn_mfma_f32_32x32x16_bf16(kf_, qf[(i) >> 1], P1, 0, 0, 0); else P0 = __builtin_amdgcn_mfma_f32_32x32x16_bf16(kf_, qf[(i) >> 1], P0, 0, 0, 0); } while (0)
    float sacc = 0.f;
#define ATT_FIN(P0, P1, i) do { constexpr int lo_ = ((i) * 32) / NQ, hi_ = (((i) + 1) * 32) / NQ; \
        _Pragma("unroll") for (int e = lo_; e < hi_; ++e) { if (e < 16) { P0[e] = __builtin_amdgcn_exp2f(P0[e]); sacc += P0[e]; } else { P1[e - 16] = __builtin_amdgcn_exp2f(P1[e - 16]); sacc += P1[e - 16]; } } \
        _Pragma("unroll") for (int e = lo_; e < hi_; ++e) if (e & 1) { const int w_ = (e >> 1) & 3, k_ = e >> 3; pw[k_][w_] = (e < 16) ? cvtpk(P0[e - 1], P0[e]) : cvtpk(P1[e - 17], P1[e - 16]); } \
        ATT_PIN(sacc); } while (0)
    constexpr int PDV = 2;
    s16x4 vlo[PDV], vhi[PDV];
#define ATT_VRD(vbs, i, k) do { vlo[k] = vtr((vbs) + (i) * 1024); vhi[k] = vtr((vbs) + (i) * 1024 + 512); } while (0)
#define ATT_PV(vbs, i) do { const s16x4 lo_ = vlo[(i) % PDV], hh_ = vhi[(i) % PDV]; if ((i) + PDV < NPV) ATT_VRD(vbs, (i) + PDV, (i) % PDV); \
        const bf16x8 vf_ = (bf16x8){lo_[0], lo_[1], lo_[2], lo_[3], hh_[0], hh_[1], hh_[2], hh_[3]}; \
        o[(i) >> 2] = __builtin_amdgcn_mfma_f32_32x32x16_bf16(__builtin_bit_cast(bf16x8, pw[(i) & 3]), vf_, o[(i) >> 2], 0, 0, 0); } while (0)
    auto decide = [&](f32x16& P0, f32x16& P1) {
        asm volatile("s_nop 15\n\ts_nop 7" : "+v"(P0), "+v"(P1));
        float xa = max3f(P0[0], P0[1], P1[0]), xb = max3f(P0[2], P0[3], P1[1]); xa = max3f(xa, P1[2], P1[3]);
#pragma unroll
        for (int r = 4; r < 16; r += 4) { xa = max3f(xa, P0[r], P0[r + 1]); xb = max3f(xb, P0[r + 2], P0[r + 3]); xa = max3f(xa, P1[r], P1[r + 1]); xb = max3f(xb, P1[r + 2], P1[r + 3]); }
        float rm = fmaxf(xa, xb);
        { auto rr = __builtin_amdgcn_permlane32_swap(__float_as_uint(rm), __float_as_uint(rm), false, false); rm = fmaxf(__uint_as_float(rr[0]), __uint_as_float(rr[1])); }
        if (__any(rm > THR)) {
            const float dl = fmaxf(rm, 0.f), al = __builtin_amdgcn_exp2f(-dl);
            mrun += dl; lrun *= al;
#pragma unroll
            for (int r = 0; r < 16; ++r) { P0[r] -= dl; P1[r] -= dl; negm[r] = -mrun; }
            if (hi == 0) wsf[r32] = al;
#pragma unroll
            for (int r = 0; r < 16; ++r) { const float a_ = wsf[crow(r, hi)];
#pragma unroll
                for (int db = 0; db < NDB; ++db) o[db][r] *= a_; }
        }
    };
    f32x16 pA0, pA1, pB0, pB1;
#define ATT_STEP(C0, C1, N0, N1, t_) do { \
        const int t__ = (t_); const bool more_ = (t__ + 1 < NT); \
        if constexpr (!(PR & 1)) { if (t__ + 2 < NT) { if constexpr (NPER == 2) ATT_WAIT_BAR(2); else ATT_WAIT_BAR(3); } else ATT_WAIT_BAR(0); }     \
        if constexpr (!(PR & 2)) { if (t__ + 3 < NT) issue_t(t__ + 3); } \
        const ALAS unsigned char* cur_ = lds + (t__ % NSLOT) * SLOT; const ALAS unsigned char* nxt_ = lds + ((t__ + 1) % NSLOT) * SLOT; \
        const ALAS unsigned char* kbs_ = nxt_ + hi * 1024 + r32 * 16; const ALAS unsigned char* vbs_ = cur_ + KB + vp; \
        sacc = 0.f; \
        if (more_) { \
            _Pragma("unroll") for (int i_ = 0; i_ < PDK; ++i_) kbuf[i_] = ATT_KRD(kbs_, i_); \
            __builtin_amdgcn_sched_barrier(0); \
            ATT_UNROLL_QK(C0, C1, N0, N1, kbs_) \
        } else { _Pragma("unroll") for (int i_ = 0; i_ < NQ; ++i_) { ATT_FIN_DYN(C0, C1, i_); } } \
        lrun += sacc; \
        _Pragma("unroll") for (int i_ = 0; i_ < PDV; ++i_) ATT_VRD(vbs_, i_, i_); \
        __builtin_amdgcn_sched_barrier(0); \
        __builtin_amdgcn_s_setprio(1); \
        ATT_UNROLL_PV(vbs_) \
        __builtin_amdgcn_s_setprio(0); \
        if constexpr (!(PR & 32)) { if (more_) decide(N0, N1); } \
    } while (0)
#define ATT_G(C0, C1, N0, N1, kbs, i) if constexpr ((i) < NQ) { if constexpr (!(PR & 16)) { ATT_QK(N0, N1, kbs, i); } if constexpr (!(PR & 4)) { ATT_FIN(C0, C1, i); } __builtin_amdgcn_sched_barrier(0); }
#define ATT_UNROLL_QK(C0, C1, N0, N1, kbs) ATT_G(C0, C1, N0, N1, kbs, 0) ATT_G(C0, C1, N0, N1, kbs, 1) ATT_G(C0, C1, N0, N1, kbs, 2) ATT_G(C0, C1, N0, N1, kbs, 3) ATT_G(C0, C1, N0, N1, kbs, 4) ATT_G(C0, C1, N0, N1, kbs, 5) \
        ATT_G(C0, C1, N0, N1, kbs, 6) ATT_G(C0, C1, N0, N1, kbs, 7) ATT_G(C0, C1, N0, N1, kbs, 8) ATT_G(C0, C1, N0, N1, kbs, 9) ATT_G(C0, C1, N0, N1, kbs, 10) ATT_G(C0, C1, N0, N1, kbs, 11)
#define ATT_FIN_DYN(C0, C1, i) do { if ((i) == 0) ATT_FIN(C0, C1, 0); else if ((i) == 1) ATT_FIN(C0, C1, 1); else if ((i) == 2) ATT_FIN(C0, C1, 2); else if ((i) == 3) ATT_FIN(C0, C1, 3); else if ((i) == 4) ATT_FIN(C0, C1, 4); else if ((i) == 5) ATT_FIN(C0, C1, 5); \
        else if ((i) == 6) ATT_FIN(C0, C1, 6); else if ((i) == 7) ATT_FIN(C0, C1, 7); else if ((i) == 8) { if constexpr (NQ > 8) ATT_FIN(C0, C1, 8); } else if ((i) == 9) { if constexpr (NQ > 8) ATT_FIN(C0, C1, 9); } else if ((i) == 10) { if constexpr (NQ > 8) ATT_FIN(C0, C1, 10); } else { if constexpr (NQ > 8) ATT_FIN(C0, C1, 11); } } while (0)
#define ATT_H(vbs, i) if constexpr ((i) < NPV) { if constexpr (!(PR & 8)) { ATT_PV(vbs, i); } __builtin_amdgcn_sched_barrier(0); }
#define ATT_UNROLL_PV(vbs) ATT_H(vbs, 0) ATT_H(vbs, 1) ATT_H(vbs, 2) ATT_H(vbs, 3) ATT_H(vbs, 4) ATT_H(vbs, 5) ATT_H(vbs, 6) ATT_H(vbs, 7) ATT_H(vbs, 8) ATT_H(vbs, 9) ATT_H(vbs, 10) ATT_H(vbs, 11) ATT_H(vbs, 12) ATT_H(vbs, 13) ATT_H(vbs, 14) ATT_H(vbs, 15)
    issue_t(0); issue_t(1); issue_t(2);
    if constexpr (NPER == 2) ATT_WAIT_BAR(4); else ATT_WAIT_BAR(6);
    {
        const ALAS unsigned char* kbs_ = lds + hi * 1024 + r32 * 16;
#pragma unroll
        for (int i_ = 0; i_ < PDK; ++i_) kbuf[i_] = ATT_KRD(kbs_, i_);
#pragma unroll
        for (int i_ = 0; i_ < NQ; ++i_) { ATT_QK(pA0, pA1, kbs_, i_); }
        decide(pA0, pA1);
    }
    for (int t = 0; t < NT; t += 2) {
        ATT_STEP(pA0, pA1, pB0, pB1, t);
        ATT_STEP(pB0, pB1, pA0, pA1, t + 1);
    }
    { auto rr = __builtin_amdgcn_permlane32_swap(__float_as_uint(lrun), __float_as_uint(lrun), false, false); lrun = __uint_as_float(rr[0]) + __uint_as_float(rr[1]); }
    if (hi == 0) wsf[32 + r32] = lrun;
    ATT_WAIT_BAR(0);
#undef ATT_KRD
#undef ATT_QK
#undef ATT_FIN
#undef ATT_VRD
#undef ATT_PV
#undef ATT_STEP
#undef ATT_G
#undef ATT_UNROLL_QK
#undef ATT_FIN_DYN
#undef ATT_H
#undef ATT_UNROLL_PV
}

template <int DV>
__device__ __forceinline__ void store_o(ALAS unsigned char* lds, const f32x16 (&o)[DV / 32], bf16_t* dst  , int ldo, int wid, int lane) {
    asm volatile("" : "+v"(lane));
    const int r32 = lane & 31, hi = lane >> 5;
    ALAS bf16_t* stg = (ALAS bf16_t*)(lds + wid * 8192);
#pragma unroll
    for (int r = 0; r < 16; ++r) { const int orow = crow(r, hi);
#pragma unroll
        for (int db = 0; db < DV / 32; ++db) { const unsigned w = cvtpk(o[db][r], 0.f); stg[orow * DV + db * 32 + r32] = (bf16_t)(w & 0xffffu); } }
    constexpr int CH = DV / 8, RPI = 64 / CH;
#pragma unroll
    for (int i = 0; i < 32 / RPI; ++i) { const int row = i * RPI + lane / CH, ch = lane % CH;
        const u32x4 v = *(const ALAS u32x4*)(stg + row * DV + ch * 8); *(AGAS u32x4*)(dst + (size_t)row * ldo + ch * 8) = v; }
}

struct Bufs {
    bf16_t *QN, *QR, *MK, *MV, *KR, *DQ, *DK, *DV_, *SQ, *SK, *SV;
    bf16_t *OA, *OB, *OC; int dry;
    unsigned* O0S;
    const float* lam; const float* dnorm; const float* sink; float lam_init; float eps;
};
template <int PR>
__device__ __forceinline__ void attn_unit(ALAS unsigned char* lds, const Bufs& B, int type, int b, int h, int qb, int wid, int lane) {
    asm volatile("" : "+v"(lane));
    const bool ctxq = (qb == 16);
    const int qrow0 = ctxq ? (16384 + b * 256) : (b * 4096 + qb * 256);
    const int tq0 = qb * 256;
    Src S; S.ctx_row0 = 16384 + b * 256; S.k2 = nullptr; S.ldk2 = 0; S.probe = B.dry ? ATT_PROBE : 0;
    const int r32 = lane & 31, hi = lane >> 5;
    ALAS float* wsf = (ALAS float*)(lds + WSF_OFF) + wid * 64;
    if (type == 0) {
        S.k1 = B.MK + h * 64; S.ldk1 = 512; S.k2 = B.KR; S.ldk2 = 32; S.v = B.MV + h * 64; S.ldv = 512;
        S.lat_row0 = b * 4096; S.nlat = ctxq ? 0 : 64;
        f32x16 o[2];
        if (ATT_PIPE && !ctxq) attn_pass2<96, 64, PR>(lds, S, B.QN + (size_t)qrow0 * 512 + h * 64, 512, B.QR + (size_t)qrow0 * 256 + h * 32, 256, o, wid, lane);
        else attn_pass<96, 64, 0>(lds, S, B.QN + (size_t)qrow0 * 512 + h * 64, 512, B.QR + (size_t)qrow0 * 256 + h * 32, 256, 0.f, tq0, 0, o, wid, lane);
#pragma unroll
        for (int r = 0; r < 16; ++r) { const float il = __builtin_amdgcn_rcpf(wsf[32 + crow(r, hi)]); o[0][r] *= il; o[1][r] *= il; }
        if (!B.dry) store_o<64>(lds, o, B.OA + (size_t)(qrow0 + wid * 32) * 512 + h * 64, 512, wid, lane);
    } else if (type == 2) {
        const int hk = h >> 2;
        S.k1 = B.SK + hk * 64; S.ldk1 = 128; S.v = B.SV + hk * 64; S.ldv = 128;
        int lo = tq0 - 128; if (lo < 0) lo = 0; int hi_ = tq0 + 256 + 128; if (hi_ > 4096) hi_ = 4096;
        S.lat_row0 = b * 4096 + lo; S.nlat = ctxq ? 0 : (hi_ - lo) / 64;
        f32x16 o[2];
        attn_pass<64, 64, 1>(lds, S, B.SQ + (size_t)qrow0 * 512 + h * 64, 512, nullptr, 0, *(const AGAS float*)(B.sink + h) * 1.4426950408889634f, tq0, lo, o, wid, lane);
#pragma unroll
        for (int r = 0; r < 16; ++r) { const float il = __builtin_amdgcn_rcpf(wsf[32 + crow(r, hi)]); o[0][r] *= il; o[1][r] *= il; }
        if (!B.dry) store_o<64>(lds, o, B.OC + (size_t)(qrow0 + wid * 32) * 512 + h * 64, 512, wid, lane);
    } else {
        S.v = B.DV_ + h * 128; S.ldv = 512; S.lat_row0 = b * 4096; S.nlat = ctxq ? 0 : 64; S.ldk1 = 512;
        f32x16 o1[4];
        S.k1 = B.DK + (2 * h) * 64;
        if (ATT_PIPE && !ctxq) attn_pass2<64, 128, PR>(lds, S, B.DQ + (size_t)qrow0 * 512 + (2 * h) * 64, 512, nullptr, 0, o1, wid, lane);
        else attn_pass<64, 128, 0>(lds, S, B.DQ + (size_t)qrow0 * 512 + (2 * h) * 64, 512, nullptr, 0, 0.f, tq0, 0, o1, wid, lane);
        unsigned* o0s = B.O0S + wid * 2048 + lane * 4;
#pragma unroll
        for (int db = 0; db < 4; ++db)
#pragma unroll
            for (int q4 = 0; q4 < 2; ++q4) { u32x4 w;
#pragma unroll
                for (int e = 0; e < 4; ++e) { const int r = 8 * q4 + 2 * e; const float il0 = __builtin_amdgcn_rcpf(wsf[32 + crow(r, hi)]), il1 = __builtin_amdgcn_rcpf(wsf[32 + crow(r + 1, hi)]); w[e] = cvtpk(o1[db][r] * il0, o1[db][r + 1] * il1); }
                *(AGAS u32x4*)(o0s + (db * 2 + q4) * 256) = w; }
        asm volatile("" : "+v"(o0s));
        S.k1 = B.DK + (2 * h + 1) * 64;
        if (ATT_PIPE && !ctxq) attn_pass2<64, 128, PR>(lds, S, B.DQ + (size_t)qrow0 * 512 + (2 * h + 1) * 64, 512, nullptr, 0, o1, wid, lane);
        else attn_pass<64, 128, 0>(lds, S, B.DQ + (size_t)qrow0 * 512 + (2 * h + 1) * 64, 512, nullptr, 0, 0.f, tq0, 0, o1, wid, lane);
        unsigned o0p[4][8];
#pragma unroll
        for (int db = 0; db < 4; ++db)
#pragma unroll
            for (int q4 = 0; q4 < 2; ++q4) { const u32x4 w = *(const AGAS u32x4*)(o0s + (db * 2 + q4) * 256);
#pragma unroll
                for (int e = 0; e < 4; ++e) o0p[db][4 * q4 + e] = w[e]; }
        int r32b = r32; asm volatile("" : "+v"(r32b));
        const float lam = *(const AGAS float*)B.lam, post = 1.0f - B.lam_init;
        float wn[4];
#pragma unroll
        for (int db = 0; db < 4; ++db) wn[db] = *(const AGAS float*)(B.dnorm + db * 32 + r32b) * post;
#pragma unroll
        for (int r = 0; r < 16; ++r) {
            const float il = __builtin_amdgcn_rcpf(wsf[32 + crow(r, hi)]) * lam;
            float ss = 0.f;
#pragma unroll
            for (int db = 0; db < 4; ++db) { const unsigned w = o0p[db][r >> 1]; const float a0 = (r & 1) ? __uint_as_float(w & 0xffff0000u) : __uint_as_float(w << 16);
                const float v = a0 - il * o1[db][r]; o1[db][r] = v; ss += v * v; }
            ss += __shfl_xor(ss, 1); ss += __shfl_xor(ss, 2); ss += __shfl_xor(ss, 4); ss += __shfl_xor(ss, 8); ss += __shfl_xor(ss, 16);
            const float rs = rsqrtf(ss * (1.0f / 128.0f) + B.eps);
#pragma unroll
            for (int db = 0; db < 4; ++db) o1[db][r] *= rs * wn[db];
        }
        if (!B.dry) store_o<128>(lds, o1, B.OB + (size_t)(qrow0 + wid * 32) * 512 + h * 128, 512, wid, lane);
    }
    ATT_WAIT_BAR(0);
}
#undef ALAS
#undef AGAS
}


constexpr int NWAVES = 8;
constexpr int DM = 1024, NB = 4, SEQ = 4096, NCTX = 256, MLAT = NB * SEQ, MCTX = NB * NCTX, MALL = MLAT + MCTX;
constexpr int PAN_LAT = MLAT / 256, PAN_ALL = MALL / 256;
constexpr int INW = 5920, DFF = 2816;
constexpr float EPS = 1e-6f, LOG2E = 1.4426950408889634f;

constexpr size_t MiB = 1u << 20;
constexpr size_t WS_CTL = 0, CTL_BYTES = 1 * MiB;
constexpr size_t WS_W = 1 * MiB;
constexpr size_t W_IN = 0, W_G = W_IN + 3072ull * 1024 * 2, W_UKVQ = W_G + 3072ull * 1024 * 2, W_ABC = W_UKVQ + 1792ull * 256 * 2, W_O = W_ABC + 3ull * 1024 * 512 * 2,
                 W_GU = W_O + 1024ull * 1024 * 2, W_DN = W_GU + 5632ull * 1024 * 2, W_END = W_DN + 1024ull * 2816 * 2;
static_assert(W_END <= 37 * MiB, "weights region");
constexpr size_t WS_H = 38 * MiB;
constexpr size_t WS_QKV = 72 * MiB;
constexpr size_t SZ512 = (size_t)MALL * 512 * 2, SZ256 = (size_t)MALL * 256 * 2, SZ128 = (size_t)MALL * 128 * 2, SZ32 = (size_t)MALL * 32 * 2;
constexpr size_t Q_ABC = WS_QKV;
constexpr size_t Q_DEAD = Q_ABC + 3 * SZ512;
constexpr size_t Q_QR = Q_DEAD, Q_MK = Q_QR + SZ256, Q_MV = Q_MK + SZ512, Q_KR = Q_MV + SZ512, Q_DK = Q_KR + SZ32, Q_DV = Q_DK + SZ512, Q_SK = Q_DV + SZ512, Q_SV = Q_SK + SZ128,
                 Q_CKVQ = Q_SV + SZ128  , Q_END = Q_CKVQ + 2 * SZ256;
constexpr size_t Q_G = Q_DEAD;
static_assert(Q_G + (size_t)MALL * 3072 * 2 <= Q_END, "gates overlay");
constexpr size_t Q_Y = Q_DEAD;
constexpr size_t Q_ACT = WS_QKV;
constexpr size_t Q_F2 = Q_ACT + (size_t)MALL * 2816 * 2;
constexpr size_t WS_CTXRES = Q_F2 + (size_t)MALL * 1024 * 4;
constexpr size_t WS_SS = WS_CTXRES + (size_t)MCTX * 1024 * 4;
constexpr size_t WS_END = WS_SS + 2ull * MALL * 4 * 4;
static_assert(Q_END <= Q_F2 + (size_t)MALL * 1024 * 4 || true, "");
static_assert(WS_END <= 239 * MiB, "d_ws map");
static_assert(Q_END <= WS_CTXRES, "attention operands below the small buffers");
constexpr int CW_BAR = 4096;
constexpr int CW_MODS = 16384;
constexpr int CW_LAM = CW_MODS + 2 * 5 * 6144;
constexpr int CW_TAB = CW_LAM + 64;
static_assert((CW_TAB + 3072) * 4 <= (int)CTL_BYTES, "CTL");

constexpr int RING_BYTES = 131072, LDSCTL_OFF = RING_BYTES, MISC_OFF = LDSCTL_OFF + 320, LDS_BYTES = 147456;
static_assert(att::LDS_NEED <= RING_BYTES, "attention LDS");

#define GAS __attribute__((address_space(1)))
#define LAS __attribute__((address_space(3)))
typedef unsigned short bf16;
typedef unsigned v4u __attribute__((ext_vector_type(4)));
typedef float f32x4 __attribute__((ext_vector_type(4)));
typedef short bf16x8 __attribute__((ext_vector_type(8)));
typedef GAS unsigned gu32;
typedef GAS unsigned long long gu64;
#define RLX_AGENT __ATOMIC_RELAXED, __HIP_MEMORY_SCOPE_AGENT
#define LDS_WAIT() asm volatile("s_waitcnt lgkmcnt(0)" ::: "memory")
#define VM_WAIT() asm volatile("s_waitcnt vmcnt(0)" ::: "memory")
__device__ __forceinline__ unsigned long long rt() { return __builtin_amdgcn_s_memrealtime(); }
__device__ __forceinline__ unsigned f2bf(float f) { unsigned u = __builtin_bit_cast(unsigned, f); return (u + 0x7fffu + ((u >> 16) & 1u)) >> 16; }
__device__ __forceinline__ unsigned pk2(float lo, float hi) { return f2bf(lo) | (f2bf(hi) << 16); }

#define XB_TMO      128
#define XB_XCNT(j)  (256  + 64 * (j))
#define XB_XSUB(j)  (1280 + 64 * (j))
#define XB_XGEN(j)  (2304 + 64 * (j))
#define XB_TOP      3328
#define XB_TOPGEN   3392
#define XCD_BAR_WORDS 3456
#define XB_SPIN_CAP (1u << 26)

__device__ __forceinline__ unsigned xb_ld(unsigned* p)              { return __hip_atomic_load(p, __ATOMIC_RELAXED, __HIP_MEMORY_SCOPE_AGENT); }
__device__ __forceinline__ unsigned xb_add(unsigned* p, unsigned v) { return __hip_atomic_fetch_add(p, v, __ATOMIC_RELAXED, __HIP_MEMORY_SCOPE_AGENT); }
__device__ __forceinline__ unsigned xb_xcc_id() { return (unsigned)__builtin_amdgcn_s_getreg((3 << 11) | 20) & 0xFu; }
#define XB_SPIN(cond, bar) do { unsigned _sp = 0; while (cond) { __builtin_amdgcn_s_sleep(1); \
    if ((++_sp & 255u) == 0u) { if (xb_ld(&(bar)[XB_TMO])) break; if (_sp > XB_SPIN_CAP) { atomicAdd(&(bar)[XB_TMO], 1u); break; } } } } while (0)

struct XcdBarrier {
    unsigned* bar; unsigned x;
    volatile LAS unsigned* st;
};

__device__ __forceinline__ XcdBarrier xcd_barrier_post(unsigned* bar, volatile LAS unsigned* st) {
    XcdBarrier b; b.bar = bar; b.x = xb_xcc_id(); b.st = st;
    if (threadIdx.x == 0) (void)xb_add(&bar[XB_XCNT(b.x)], 1u);
    return b;
}
__device__ __forceinline__ void xcd_barrier_complete(unsigned* bar, unsigned x, unsigned& nloc, unsigned& nx) {
    const unsigned G = gridDim.x * gridDim.y * gridDim.z;
    unsigned sum, cnt, mine, sp = 0u;
    for (;;) {
        sum = 0u; cnt = 0u; mine = 0u;
#pragma unroll
        for (unsigned j = 0; j < 16; ++j) { const unsigned c = xb_ld(&bar[XB_XCNT(j)]); sum += c; cnt += (c > 0u) ? 1u : 0u; mine = (j == x) ? c : mine; }
        if (sum == G) break;
        __builtin_amdgcn_s_sleep(1);
        if ((++sp & 255u) == 0u) { if (xb_ld(&bar[XB_TMO])) break; if (sp > XB_SPIN_CAP) { atomicAdd(&bar[XB_TMO], 1u); break; } }
    }
    nloc = mine > 0u ? mine : 1u; nx = cnt > 0u ? cnt : 1u;
}

__device__ __forceinline__ void xcd_barrier(const XcdBarrier& b, const bool is_t0) {
    asm volatile("s_waitcnt vmcnt(0)" ::: "memory");
    __syncthreads();
    if (is_t0) {
        unsigned* bar = b.bar;
        __builtin_amdgcn_s_waitcnt(0);
        unsigned nloc = b.st[0], nx = b.st[1];
        if (nloc == 0u) { xcd_barrier_complete(bar, b.x, nloc, nx); b.st[0] = nloc; b.st[1] = nx; }
        const unsigned old = xb_add(&bar[XB_XSUB(b.x)], 1u);
        const unsigned gen = old / nloc;
        if (old + 1u == (gen + 1u) * nloc) {
            __builtin_amdgcn_fence(__ATOMIC_RELEASE, "agent");
            asm volatile("s_waitcnt vmcnt(0)" ::: "memory");
            const unsigned og = xb_add(&bar[XB_TOP], 1u);
            const unsigned tg = og / nx;
            if (og + 1u == (tg + 1u) * nx) xb_add(&bar[XB_TOPGEN], 1u);
            else XB_SPIN(xb_ld(&bar[XB_TOPGEN]) == tg, bar);
            __builtin_amdgcn_fence(__ATOMIC_ACQUIRE, "agent");
            xb_add(&bar[XB_XGEN(b.x)], 1u);
            asm volatile("s_waitcnt vmcnt(0)" ::: "memory");
        } else {
            XB_SPIN(xb_ld(&bar[XB_XGEN(b.x)]) == gen, bar);
            __builtin_amdgcn_fence(__ATOMIC_ACQUIRE, "agent");
            asm volatile("s_waitcnt vmcnt(0)" ::: "memory");
        }
    }
    __syncthreads();
}

struct Ptrs {
    const float* in[24]; float* out; unsigned char* ws;
};
__device__ __forceinline__ float wave_sum(float v) {
#pragma unroll
    for (int o = 1; o < 64; o <<= 1) v += __shfl_xor(v, o);
    return v;
}
__device__ __forceinline__ float silu_acc(float x) { return x / (1.f + expf(-x)); }

__device__ __forceinline__ void p0_transpose_item(const float* W, int K, int Nsrc, int lcol0, const float* kscale, bf16* WT, int n0, int k0, LAS float* scr, int lane) {
    if (lcol0 < 0) {
        unsigned z = 0u; asm volatile("" : "+v"(z));
#pragma unroll
        for (int j = 0; j < 4; ++j) { const int n = (lane >> 3) + 8 * j; *(GAS v4u*)(WT + (size_t)(n0 + n) * K + k0 + 8 * (lane & 7)) = (v4u){z, z, z, z}; }
        return;
    }
#pragma unroll 16
    for (int i = 0; i < 32; ++i) { const int kk = 2 * i + (lane >> 5); float v = *(const GAS float*)(W + (size_t)(k0 + kk) * Nsrc + lcol0 + (lane & 31)); if (kscale) v *= *(const GAS float*)(kscale + k0 + kk); scr[kk * 33 + (lane & 31)] = v; }
    LDS_WAIT(); asm volatile("" ::: "memory");
    const int c = lane & 7;
#pragma unroll
    for (int j = 0; j < 4; ++j) { const int n = (lane >> 3) + 8 * j; const LAS float* s = scr + (8 * c) * 33 + n;
        v4u o; o.x = pk2(s[0 * 33], s[1 * 33]); o.y = pk2(s[2 * 33], s[3 * 33]); o.z = pk2(s[4 * 33], s[5 * 33]); o.w = pk2(s[6 * 33], s[7 * 33]);
        *(GAS v4u*)(WT + (size_t)(n0 + n) * K + k0 + 8 * c) = o; }
    LDS_WAIT(); asm volatile("" ::: "memory");
}
__device__ __forceinline__ void convert_weights(volatile LAS unsigned long long* PT, int l, unsigned char* wsW, LAS float* scr, int gw, int NGW, int lane, int which = 0) {
    const float* w_in = ((const float*)PT[10]) + (size_t)l * DM * INW; const float* q_norm = ((const float*)PT[11]) + l * 256; const float* w_uq = ((const float*)PT[12]) + (size_t)l * 256 * 768;
    const float* kv_norm = ((const float*)PT[13]) + l * 256; const float* w_ukv = ((const float*)PT[14]) + (size_t)l * 256 * 1024;
    const float* w_o = ((const float*)PT[21]) + (size_t)l * DM * DM; const float* w_gu = ((const float*)PT[22]) + (size_t)l * DM * 2 * DFF; const float* w_dn = ((const float*)PT[23]) + (size_t)l * DFF * DM;
    constexpr int I_IN = 16 * 96, I_G = 16 * 96, I_KV = 4 * 32, I_Q = 4 * 24, I_BR = 8 * 32, I_O = 16 * 32, I_GU = 16 * 176, I_DN = 44 * 32;
    constexpr int NITEMS = I_IN + I_G + I_KV + I_Q + 3 * I_BR + I_O + I_GU + I_DN;
    const int it_lo = (which == 2) ? NITEMS - I_DN : 0, it_hi = (which == 1) ? NITEMS - I_DN : NITEMS;
    for (int it = it_lo + gw; it < it_hi; it += NGW) {
        int r = it;
        if (r < I_IN) { const int kb = r / 96, nb = r % 96, n0 = nb * 32; int lc;
            if (n0 < 256) lc = n0; else if (n0 < 1536) lc = n0 + 32; else if (n0 < 1568) lc = 256 + (n0 - 1536); else if (n0 < 1792) lc = -1; else lc = 1568 + (n0 - 1792);
            p0_transpose_item(w_in, DM, INW, lc, nullptr, (bf16*)(wsW + W_IN), n0, kb * 64, scr, lane); continue; } r -= I_IN;
        if (r < I_G) { const int kb = r / 96, nb = r % 96; p0_transpose_item(w_in, DM, INW, 2848 + nb * 32, nullptr, (bf16*)(wsW + W_G), nb * 32, kb * 64, scr, lane); continue; } r -= I_G;
        if (r < I_KV) { const int kb = r / 32, nb = r % 32; p0_transpose_item(w_ukv, 256, 1024, nb * 32, kv_norm, (bf16*)(wsW + W_UKVQ), nb * 32, kb * 64, scr, lane); continue; } r -= I_KV;
        if (r < I_Q) { const int kb = r / 24, nb = r % 24; p0_transpose_item(w_uq, 256, 768, nb * 32, q_norm, (bf16*)(wsW + W_UKVQ) + 1024 * 256, nb * 32, kb * 64, scr, lane); continue; } r -= I_Q;
        if (r < 3 * I_BR) { const int br = r / I_BR, rr = r % I_BR, kb = rr / 32, nb = rr % 32; p0_transpose_item(((const float*)PT[18 + br]) + (size_t)l * 512 * DM, 512, DM, nb * 32, nullptr, (bf16*)(wsW + W_ABC) + (size_t)br * 1024 * 512, nb * 32, kb * 64, scr, lane); continue; } r -= 3 * I_BR;
        if (r < I_O) { const int kb = r / 32, nb = r % 32; p0_transpose_item(w_o, DM, DM, nb * 32, nullptr, (bf16*)(wsW + W_O), nb * 32, kb * 64, scr, lane); continue; } r -= I_O;
        if (r < I_GU) { const int kb = r / 176, nb = r % 176, n0 = nb * 32, tile = n0 >> 8, bj = (n0 >> 7) & 1, c = n0 & 127;
            p0_transpose_item(w_gu, DM, 2 * DFF, bj * DFF + tile * 128 + c, nullptr, (bf16*)(wsW + W_GU), n0, kb * 64, scr, lane); continue; } r -= I_GU;
        { const int kb = r / 32, nb = r % 32; p0_transpose_item(w_dn, DFF, DM, nb * 32, nullptr, (bf16*)(wsW + W_DN), nb * 32, kb * 64, scr, lane); }
    }
}
__device__ __forceinline__ void adaln_item(volatile LAS unsigned long long* PT, int item, float* part, int lane) {
    const int l = item / (24 * 32), rem = item % (24 * 32), cc = rem / 32, kc = rem % 32, n = cc * 256 + 4 * lane;
    const float* W = ((const float*)PT[4]) + (size_t)l * DM * 6144 + (size_t)(kc * 32) * 6144 + n;
    const float* cB = (const float*)PT[1]; const float* cC = (const float*)PT[3];
    f32x4 acc[5];
#pragma unroll
    for (int c = 0; c < 5; ++c) acc[c] = (f32x4){0.f, 0.f, 0.f, 0.f};
#pragma unroll
    for (int kb = 0; kb < 2; ++kb) {
        f32x4 w4[16];
#pragma unroll
        for (int k = 0; k < 16; ++k) w4[k] = *(const GAS f32x4*)(W + (size_t)(kb * 16 + k) * 6144);
#pragma unroll
        for (int k = 0; k < 16; ++k) { const int kk = kc * 32 + kb * 16 + k;
#pragma unroll
            for (int c = 0; c < 5; ++c) { const float s = silu_acc(c < 4 ? *(const GAS float*)(cB + c * DM + kk) : *(const GAS float*)(cC + kk)); acc[c] += w4[k] * s; } }
    }
#pragma unroll
    for (int c = 0; c < 5; ++c) *(GAS f32x4*)(part + (((size_t)l * 32 + kc) * 5 + c) * 6144 + n) = acc[c];
}
__device__ __forceinline__ void row_prenorm(const f32x4 (&x)[4], const float* wpre, const float* shift, const float* scale, bf16* hout, int lane) {
    float ss = 0.f;
#pragma unroll
    for (int j = 0; j < 4; ++j) ss += (x[j][0] * x[j][0] + x[j][1] * x[j][1]) + (x[j][2] * x[j][2] + x[j][3] * x[j][3]);
    const float rs = rsqrtf(wave_sum(ss) * (1.0f / DM) + EPS);
#pragma unroll
    for (int j = 0; j < 4; ++j) { const int e = 4 * lane + 256 * j;
        const f32x4 w = *(const GAS f32x4*)(wpre + e), sh = *(const GAS f32x4*)(shift + e), sc = *(const GAS f32x4*)(scale + e);
        const f32x4 h = (x[j] * rs * w) * (sc + 1.0f) + sh;
        unsigned long long o = (unsigned long long)pk2(h[0], h[1]) | ((unsigned long long)pk2(h[2], h[3]) << 32);
        *(GAS unsigned long long*)(hout + e) = o; }
}
__device__ __forceinline__ void row_post(const float* res, const bf16* y, const float* wpost, const float* gate, float* res_out, const float* wpre, const float* shift, const float* scale, bf16* hout, int lane) {
    f32x4 yv[4], xv[4]; float ss = 0.f;
#pragma unroll
    for (int j = 0; j < 4; ++j) { const int e = 4 * lane + 256 * j; { const unsigned long long yw = *(const GAS unsigned long long*)(y + e); const unsigned lo = (unsigned)yw, hi = (unsigned)(yw >> 32); yv[j] = (f32x4){__uint_as_float(lo << 16), __uint_as_float(lo & 0xffff0000u), __uint_as_float(hi << 16), __uint_as_float(hi & 0xffff0000u)}; } xv[j] = *(const GAS f32x4*)(res + e); ss += (yv[j][0] * yv[j][0] + yv[j][1] * yv[j][1]) + (yv[j][2] * yv[j][2] + yv[j][3] * yv[j][3]); }
    const float rs = rsqrtf(wave_sum(ss) * (1.0f / DM) + EPS);
#pragma unroll
    for (int j = 0; j < 4; ++j) { const int e = 4 * lane + 256 * j; const f32x4 w = *(const GAS f32x4*)(wpost + e), g = *(const GAS f32x4*)(gate + e);
        xv[j] = xv[j] + g * (yv[j] * rs * w); *(GAS f32x4*)(res_out + e) = xv[j]; }
    if (hout) row_prenorm(xv, wpre, shift, scale, hout, lane);
}


#ifdef MK_CHECK
namespace chk {
constexpr int NS = 192;
__device__ __forceinline__ int srow(int i) { return i < 64 ? 5000 + i : (i < 128 ? 16320 + (i - 64) : 16384 + 300 + (i - 128)); }
__device__ __forceinline__ float bf(unsigned short v) { return __uint_as_float((unsigned)v << 16); }
__device__ __forceinline__ void upd(float* err, float e, float ref) {
    atomicMax((int*)err, __float_as_int(fabsf(e))); atomicMax((int*)err + 1, __float_as_int(fabsf(ref)));
}
__device__ __forceinline__ float bsum(float v, float* red) {
    for (int o = 32; o > 0; o >>= 1) v += __shfl_xor(v, o);
    __syncthreads(); if ((threadIdx.x & 63) == 0) red[threadIdx.x >> 6] = v; __syncthreads();
    float t = 0.f; for (int i = 0; i < (int)(blockDim.x >> 6); ++i) t += red[i]; return t;
}
__global__ void set_tab(Ptrs p, const float** tab) { if (threadIdx.x < 24) tab[threadIdx.x] = p.in[threadIdx.x]; }
__global__ void zero_err(float* err) { for (int i = threadIdx.x; i < 256; i += blockDim.x) err[i] = 0.f; }
__global__ void encode(const float* err, float* out, size_t n, int slot) {
    float e = err[2 * slot] / fmaxf(err[2 * slot + 1], 1e-20f);
#ifdef MK_KEY
    { int am = 0; float best = -1.f, tot = 0.f; for (int s = 0; s < 32; ++s) { tot += err[64 + s]; if (err[64 + s] > best) { best = err[64 + s]; am = s; } }
      e = (slot == 0) ? (float)(1 + am) : (slot == 1 ? best / fmaxf(tot, 1.f) : tot * 1e-5f); }
#endif
    for (size_t i = (size_t)blockIdx.x * blockDim.x + threadIdx.x; i < n; i += (size_t)gridDim.x * blockDim.x) out[i] = 100000.f * e;
}
__global__ void gemm_rows(const unsigned short* A, int lda, int K, const float* W, int ldw, int N, float* Z, int ldz) {
    const int i = blockIdx.y, n = blockIdx.x * 256 + threadIdx.x; if (n >= N) return;
    const unsigned short* a = A + (size_t)srow(i) * lda; float s = 0.f;
    for (int k = 0; k < K; ++k) s += bf(a[k]) * W[(size_t)k * ldw + n];
    Z[(size_t)i * ldz + n] = s;
}
__device__ __forceinline__ float rope_val(const float* x  , int c, int d, int row) {
    const int half = d / 2, q = d / 4, axis = c / half, i = c % half, t = row & 4095, pos = axis ? (t & 63) : (t >> 6);
    const int ii = i % q; const float ang = (float)pos * powf(10000.f, -(float)(2 * ii) / (float)half); const float cs = cosf(ang), sn = sinf(ang);
    const float* xa = x + axis * half;
    return (i < q) ? xa[i] * cs - xa[i + q] * sn : xa[i] * cs + xa[i - q] * sn;
}
__global__ void cmp_p1(const float* Z, unsigned char* ws, float* err) {
    const int i = blockIdx.y, n = blockIdx.x * 256 + threadIdx.x; if (n >= 2848) return;
    const int row = srow(i); const bool lat = row < MLAT; const float* z = Z + (size_t)i * 5920; const float qs = 0.125f * LOG2E;
    float e; const unsigned short* o;
    if (n < 256) { e = z[n]; o = (unsigned short*)(ws + Q_CKVQ) + (size_t)row * 256 + n; }
    else if (n < 288) { const int c = n - 256; e = lat ? rope_val(z + 256, c, 32, row) : z[n]; o = (unsigned short*)(ws + Q_KR) + (size_t)row * 32 + c; }
    else if (n < 800) { const int c = n - 288, h = c / 64; e = lat ? rope_val(z + 288 + h * 64, c % 64, 64, row) : z[n]; o = (unsigned short*)(ws + Q_DK) + (size_t)row * 512 + c; }
    else if (n < 1312) { e = z[n]; o = (unsigned short*)(ws + Q_DV) + (size_t)row * 512 + (n - 800); }
    else if (n < 1440) { const int c = n - 1312, h = c / 64; e = lat ? rope_val(z + 1312 + h * 64, c % 64, 64, row) : z[n]; o = (unsigned short*)(ws + Q_SK) + (size_t)row * 128 + c; }
    else if (n < 1568) { e = z[n]; o = (unsigned short*)(ws + Q_SV) + (size_t)row * 128 + (n - 1440); }
    else if (n < 1824) { e = z[n]; o = (unsigned short*)(ws + Q_CKVQ) + (size_t)MALL * 256 + (size_t)row * 256 + (n - 1568); }
    else if (n < 2336) { const int c = n - 1824, h = c / 64; e = qs * (lat ? rope_val(z + 1824 + h * 64, c % 64, 64, row) : z[n]); o = (unsigned short*)(ws + Q_ABC) + (size_t)MALL * 512 + (size_t)row * 512 + c; }
    else { const int c = n - 2336, h = c / 64; e = qs * (lat ? rope_val(z + 2336 + h * 64, c % 64, 64, row) : z[n]); o = (unsigned short*)(ws + Q_ABC) + 2 * (size_t)MALL * 512 + (size_t)row * 512 + c; }
    upd(err, e - bf(*o), e);
}
__global__ void cmp_ss(const float* Z, unsigned char* ws, float* err) {
    const int i = blockIdx.x, which = threadIdx.x; if (which >= 2) return;
    const int row = srow(i); const float* z = Z + (size_t)i * 5920 + (which ? 1568 : 0); float s = 0.f;
    for (int k = 0; k < 256; ++k) s += z[k] * z[k];
    const float* S = (const float*)(ws + WS_SS) + (which ? (size_t)MALL * 4 : 0) + (size_t)row * 4;
    upd(err, s - (S[0] + S[1] + S[2] + S[3]), s);
}
__global__ void cmp_p2(const float* const* in, unsigned char* ws, float* err) {
    const int i = blockIdx.y, n = blockIdx.x * 256 + threadIdx.x; if (n >= 1792) return;
    const int row = srow(i); const bool lat = row < MLAT; const bool isq = n >= 1024;
    const unsigned short* a = (const unsigned short*)(ws + Q_CKVQ) + (isq ? (size_t)MALL * 256 : 0) + (size_t)row * 256;
    const float* S = (const float*)(ws + WS_SS) + (isq ? (size_t)MALL * 4 : 0) + (size_t)row * 4;
    const float rs = rsqrtf((S[0] + S[1] + S[2] + S[3]) / 256.f + EPS);
    const float* nw = isq ? in[11] : in[13]; const float* W = isq ? in[12] : in[14]; const int ldw = isq ? 768 : 1024;
    auto dot = [&](int col) { float s = 0.f; for (int k = 0; k < 256; ++k) s += bf(a[k]) * nw[k] * W[(size_t)k * ldw + col]; return s * rs; };
    float e; const unsigned short* o;
    if (!isq) { const int h = n / 128, j = n % 128; e = dot(n); o = (j < 64) ? (unsigned short*)(ws + Q_MK) + (size_t)row * 512 + h * 64 + j : (unsigned short*)(ws + Q_MV) + (size_t)row * 512 + h * 64 + (j - 64); }
    else { const int c = n - 1024, h = c / 96, j = c % 96; const float qs = 0.10206207261596575f * LOG2E;
        if (j < 64) { e = qs * dot(c); o = (unsigned short*)(ws + Q_ABC) + (size_t)row * 512 + h * 64 + j; }
        else { const int r = j - 64; float x;
            if (lat) { const int half = 16, q = 8, axis = r / half, ii = r % half, t = row & 4095, pos = axis ? (t & 63) : (t >> 6);
                const float ang = (float)pos * powf(10000.f, -(float)(2 * (ii % q)) / 16.f), cs = cosf(ang), sn = sinf(ang);
                const float me = dot(c), pa = dot(h * 96 + 64 + axis * half + (ii < q ? ii + q : ii - q));
                x = (ii < q) ? me * cs - pa * sn : me * cs + pa * sn; }
            else x = dot(c);
            e = qs * x; o = (unsigned short*)(ws + Q_QR) + (size_t)row * 256 + h * 32 + r; } }
    const int cat = !isq ? ((n % 128) < 64 ? 0 : 1) : (((n - 1024) % 96) < 64 ? 2 : 3);
    upd(err + 2 * cat, e - bf(*o), e);
}
__global__ void __launch_bounds__(64) cmp_attn(const float* const* in, unsigned char* ws, const unsigned short* obase, int layer, float* err) {
    __shared__ float sc[2][4352]; __shared__ float qs[96];
    const int i = blockIdx.x, h = blockIdx.y, type = blockIdx.z, lane = threadIdx.x;
    if (type == 1 && h >= 4) return;
    const int row = srow(i); const bool lat = row < MLAT; const int b = lat ? row >> 12 : (row - MLAT) >> 8, t = row & 4095;
    const int nkeys = lat ? 4352 : 256;
    auto krow = [&](int k) { return k < 256 ? MLAT + b * 256 + k : b * 4096 + (k - 256); };
    const unsigned short *QN = (unsigned short*)(ws + Q_ABC), *DQ = QN + (size_t)MALL * 512, *SQ = DQ + (size_t)MALL * 512, *QR = (unsigned short*)(ws + Q_QR), *MK = (unsigned short*)(ws + Q_MK), *MV = (unsigned short*)(ws + Q_MV),
                         *KR = (unsigned short*)(ws + Q_KR), *DK = (unsigned short*)(ws + Q_DK), *DV = (unsigned short*)(ws + Q_DV), *SK = (unsigned short*)(ws + Q_SK), *SV = (unsigned short*)(ws + Q_SV);
    float lsum[2] = {0.f, 0.f}; const int npass = type == 1 ? 2 : 1;
    for (int p = 0; p < npass; ++p) {
        __syncthreads();
        int dq = 64;
        if (type == 0) { for (int j = lane; j < 64; j += 64) qs[j] = bf(QN[(size_t)row * 512 + h * 64 + j]); if (lane < 32) qs[64 + lane] = bf(QR[(size_t)row * 256 + h * 32 + lane]); dq = 96; }
        else if (type == 1) qs[lane] = bf(DQ[(size_t)row * 512 + (2 * h + p) * 64 + lane]);
        else qs[lane] = bf(SQ[(size_t)row * 512 + h * 64 + lane]);
        __syncthreads();
        float mx = -INFINITY;
        for (int k = lane; k < nkeys; k += 64) {
            const int kr = krow(k); bool ok = true;
            if (type == 2 && k >= 256) { int dl = t - (k - 256); if (dl < 0) dl = -dl; ok = dl <= 128; }
            float s = -INFINITY;
            if (ok) { s = 0.f;
                if (type == 0) { for (int j = 0; j < 64; ++j) s += qs[j] * bf(MK[(size_t)kr * 512 + h * 64 + j]); for (int j = 0; j < 32; ++j) s += qs[64 + j] * bf(KR[(size_t)kr * 32 + j]); }
                else if (type == 1) { for (int j = 0; j < 64; ++j) s += qs[j] * bf(DK[(size_t)kr * 512 + (2 * h + p) * 64 + j]); }
                else { for (int j = 0; j < 64; ++j) s += qs[j] * bf(SK[(size_t)kr * 128 + (h >> 2) * 64 + j]); } }
            sc[p][k] = s; mx = fmaxf(mx, s);
        }
        const float sk2 = (type == 2) ? in[17][layer * 8 + h] * LOG2E : -INFINITY;
        mx = fmaxf(mx, sk2);
        for (int o = 32; o > 0; o >>= 1) mx = fmaxf(mx, __shfl_xor(mx, o));
        float sum = 0.f;
        for (int k = lane; k < nkeys; k += 64) { const float pv = exp2f(sc[p][k] - mx); sc[p][k] = pv; sum += pv; }
        for (int o = 32; o > 0; o >>= 1) sum += __shfl_xor(sum, o);
        if (type == 2) sum += exp2f(sk2 - mx);
        lsum[p] = sum; (void)dq;
    }
    __syncthreads();
    if (type != 1) {
        const unsigned short* V = type == 0 ? MV : SV; const int ldv = type == 0 ? 512 : 128, hoff = type == 0 ? h * 64 : (h >> 2) * 64;
        float acc = 0.f; for (int k = 0; k < nkeys; ++k) acc += sc[0][k] * bf(V[(size_t)krow(k) * ldv + hoff + lane]);
        const float e = acc / lsum[0]; const unsigned short* o = obase + (type == 0 ? 0 : 2) * (size_t)MALL * 512 + (size_t)row * 512 + h * 64 + lane;
        upd(err, e - bf(*o), e);
    } else {
        const float lam = *((const float*)(ws + WS_CTL) + CW_LAM + layer), lam_init = 0.8f - 0.6f * expf(-0.3f * (float)layer);
        float v[2]; float ss = 0.f;
        for (int j = 0; j < 2; ++j) { const int d = lane + 64 * j; float a0 = 0.f, a1 = 0.f;
            for (int k = 0; k < nkeys; ++k) { const float vv = bf(DV[(size_t)krow(k) * 512 + h * 128 + d]); a0 += sc[0][k] * vv; a1 += sc[1][k] * vv; }
            v[j] = a0 / lsum[0] - lam * a1 / lsum[1]; ss += v[j] * v[j]; }
        for (int o = 32; o > 0; o >>= 1) ss += __shfl_xor(ss, o);
        const float rs = rsqrtf(ss / 128.f + EPS);
        for (int j = 0; j < 2; ++j) { const int d = lane + 64 * j; const float e = v[j] * rs * in[16][layer * 128 + d] * (1.f - lam_init);
            const unsigned short* o = obase + (size_t)MALL * 512 + (size_t)row * 512 + h * 128 + d; upd(err, e - bf(*o), e); }
    }
}
__global__ void cmp_gates(const float* Z, unsigned char* ws, float* err) {
    const int i = blockIdx.y, n = blockIdx.x * 256 + threadIdx.x; if (n >= 3072) return;
    const float e = 1.f / (1.f + expf(-Z[(size_t)i * 3072 + n])); const unsigned short* o = (const unsigned short*)(ws + Q_G) + (size_t)srow(i) * 3072 + n;
    { const int row = srow(i); const bool bad = fabsf(e - bf(*o)) > 0.02f;
#ifndef MK_KEY
#define MK_KEY 0
#endif
      const int key = MK_KEY == 0 ? (n % 256) / 8 : MK_KEY == 1 ? (row % 256) / 8 : MK_KEY == 2 ? (row % 16) : MK_KEY == 3 ? (n % 32) : (n / 256);
      if (bad) atomicAdd(err + 64 + key, 1.0f); }
}
__global__ void cmp_merge(const float* const* in, unsigned char* ws, int layer, float* err) {
    const int i = blockIdx.y, n = blockIdx.x * 256 + threadIdx.x, row = srow(i); float e = 0.f;
    for (int br = 0; br < 3; ++br) { const unsigned short* a = (const unsigned short*)(ws + Q_ABC) + (size_t)br * MALL * 512 + (size_t)row * 512; const float* W = in[18 + br] + (size_t)layer * 512 * 1024; float s = 0.f;
        for (int k = 0; k < 512; ++k) s += bf(a[k]) * W[(size_t)k * 1024 + n];
        e += bf(*((const unsigned short*)(ws + Q_G) + (size_t)row * 3072 + br * 1024 + n)) * s; }
    upd(err, e - bf(*((const unsigned short*)(ws + WS_H) + (size_t)row * 1024 + n)), e);
}
__global__ void cmp_f32(const float* Z, int ldz, const float* Y, int ldy, int N, float* err) {
    const int i = blockIdx.y, n = blockIdx.x * 256 + threadIdx.x; if (n >= N) return;
    const float e = Z[(size_t)i * ldz + n]; upd(err, e - Y[(size_t)srow(i) * ldy + n], e);
}
__global__ void cmp_act(const float* Z, unsigned char* ws, float* err) {
    const int i = blockIdx.y, n = blockIdx.x * 256 + threadIdx.x; if (n >= 2816) return;
    const float g = Z[(size_t)i * 5632 + n], u = Z[(size_t)i * 5632 + 2816 + n], e = g / (1.f + expf(-g)) * u;
    upd(err, e - bf(*((const unsigned short*)(ws + Q_ACT) + (size_t)srow(i) * 2816 + n)), e);
}
__global__ void __launch_bounds__(256) cmp_rowpost(const float* const* in, unsigned char* ws, const float* outp, int layer, int which  , float* err) {
    __shared__ float red[8]; __shared__ float xs[1024];
    const int i = blockIdx.x, row = srow(i); const bool lat = row < MLAT; const int cond = lat ? row >> 12 : 4;
    const float* mods = (const float*)(ws + WS_CTL) + CW_MODS + ((size_t)layer * 5 + cond) * 6144;
    const float* y = (which == 1 ? (const float*)(ws + Q_Y) : (const float*)(ws + Q_F2)) + (size_t)row * 1024;
    (void)y; (void)mods; (void)red; (void)xs; (void)in; (void)outp; (void)err;
    if (which != 1 || layer != 0) return;
    const float* res = lat ? in[0] + (size_t)row * 1024 : in[2] + (size_t)(row - MLAT) * 1024;
    float ss = 0.f; for (int j = threadIdx.x; j < 1024; j += 256) ss += y[j] * y[j];
    ss = bsum(ss, red); const float rs = rsqrtf(ss / 1024.f + EPS);
    float s2 = 0.f;
    for (int j = threadIdx.x; j < 1024; j += 256) { const float x1 = res[j] + mods[2 * 1024 + j] * (y[j] * rs * in[7][layer * 1024 + j]); xs[j] = x1; s2 += x1 * x1;
        const float o = lat ? outp[(size_t)row * 1024 + j] : *((const float*)(ws + WS_CTXRES) + (size_t)(row - MLAT) * 1024 + j); upd(err, x1 - o, x1); }
    s2 = bsum(s2, red); const float r2 = rsqrtf(s2 / 1024.f + EPS);
    for (int j = threadIdx.x; j < 1024; j += 256) { const float hh = (xs[j] * r2 * in[8][layer * 1024 + j]) * (1.f + mods[4 * 1024 + j]) + mods[3 * 1024 + j];
        upd(err + 2, hh - bf(*((const unsigned short*)(ws + WS_H) + (size_t)row * 1024 + j)), hh); }
}
}
#endif


#ifndef MK_SIG_ALIGN
#define MK_SIG_ALIGN true
#endif
#ifndef MK_SIG_SP2
#define MK_SIG_SP2 true
#endif
#ifndef MK_ALIGN
#define MK_ALIGN true
#endif
#ifndef MK_STOP_AFTER
#define MK_STOP_AFTER 1000
#endif
__global__ void __launch_bounds__(NWAVES * 64, 2) mk_fwd(Ptrs P) {
    extern __shared__ __attribute__((aligned(16))) unsigned char lds_raw[];
    LAS unsigned char* lds = (LAS unsigned char*)lds_raw;
    volatile LAS unsigned* MISC = (volatile LAS unsigned*)(lds + MISC_OFF);
    volatile LAS unsigned long long* PT = (volatile LAS unsigned long long*)(lds + MISC_OFF + 256);
#define IN(i) ((const float*)PT[i])
#define OUTP ((float*)PT[24])
    const int tid = threadIdx.x, wave0 = __builtin_amdgcn_readfirstlane(tid >> 6);
    const int G = gridDim.x, bx = blockIdx.x, vcu = (G % 8 == 0) ? (bx % 8) * (G / 8) + bx / 8 : bx;
    unsigned char* ws = P.ws;
    gu32* ctl = (gu32*)(ws + WS_CTL);
    for (int u = tid; u < (LDS_BYTES - LDSCTL_OFF) / 4; u += NWAVES * 64) ((LAS unsigned*)(lds + LDSCTL_OFF))[u] = 0u;
    __syncthreads();
    if (tid == 0) {
#pragma unroll
        for (int i = 0; i < 24; ++i) PT[i] = (unsigned long long)P.in[i];
        PT[24] = (unsigned long long)P.out;
    }
    __syncthreads();
    (void)xcd_barrier_post((unsigned*)(ctl + CW_BAR), MISC + 8);
    int phase_no = 0;
#define GRID_BAR() do { unsigned char* wsb = ws; asm volatile("" : "+s"(wsb)); int wvb = wave0; asm volatile("" : "+s"(wvb)); XcdBarrier bar_; bar_.bar = (unsigned*)(wsb + WS_CTL) + CW_BAR; bar_.x = xb_xcc_id(); bar_.st = MISC + 8; \
        int lnb; asm volatile("v_mbcnt_lo_u32_b32 %0, -1, 0\n\tv_mbcnt_hi_u32_b32 %0, -1, %0" : "=v"(lnb)); const bool t0_ = (wvb == 0) && (lnb == 0); xcd_barrier(bar_, t0_); if (++phase_no >= MK_STOP_AFTER) goto dump_and_exit; } while (0)

#define PH_BEGIN() unsigned char* wsp = ws; asm volatile("" : "+s"(wsp)); int lane; asm volatile("v_mbcnt_lo_u32_b32 %0, -1, 0\n\tv_mbcnt_hi_u32_b32 %0, -1, %0" : "=v"(lane)); int wave = wave0; asm volatile("" : "+s"(wave)); \
    float* MODS = (float*)(wsp + WS_CTL) + CW_MODS; float* LAMS = (float*)(wsp + WS_CTL) + CW_LAM; float* TAB = (float*)(wsp + WS_CTL) + CW_TAB; \
    bf16* Hb = (bf16*)(wsp + WS_H); bf16* QN = (bf16*)(wsp + Q_ABC); bf16* DQ = QN + (size_t)MALL * 512; bf16* SQ = DQ + (size_t)MALL * 512; \
    bf16* QR = (bf16*)(wsp + Q_QR); bf16* MK = (bf16*)(wsp + Q_MK); bf16* MV = (bf16*)(wsp + Q_MV); bf16* KR = (bf16*)(wsp + Q_KR); \
    bf16* DK = (bf16*)(wsp + Q_DK); bf16* DV = (bf16*)(wsp + Q_DV); bf16* SK = (bf16*)(wsp + Q_SK); bf16* SV = (bf16*)(wsp + Q_SV); \
    bf16* CKV = (bf16*)(wsp + Q_CKVQ); bf16* CQ = CKV + (size_t)MALL * 256; \
    bf16* GT = (bf16*)(wsp + Q_G); bf16* Yb = (bf16*)(wsp + Q_Y); bf16* ACT = (bf16*)(wsp + Q_ACT); bf16* F2 = (bf16*)(wsp + Q_F2); \
    float* CTXRES = (float*)(wsp + WS_CTXRES); float* SSKV = (float*)(wsp + WS_SS); float* SSQ = SSKV + (size_t)MALL * 4; \
    unsigned char* wsW = wsp + WS_W; const int gw = vcu * NWAVES + wave, NGW = G * NWAVES; \
    (void)MODS; (void)LAMS; (void)TAB; (void)Hb; (void)QN; (void)DQ; (void)SQ; (void)QR; (void)MK; (void)MV; (void)KR; (void)DK; (void)DV; (void)SK; (void)SV; (void)CKV; (void)CQ; (void)GT; (void)Yb; (void)ACT; (void)F2; (void)CTXRES; (void)SSKV; (void)SSQ; (void)wsW; (void)gw; (void)NGW; (void)lane; (void)wave

    {
        PH_BEGIN();
        for (int it = gw; it < 2 * 24 * 32; it += NGW) adaln_item(PT, it, (float*)(wsp + WS_QKV), lane);
#ifndef MK_REP_P0
#define MK_REP_P0 1
#endif
        for (int r_ = 0; r_ < MK_REP_P0; ++r_) { convert_weights(PT, 0, wsW, (LAS float*)(lds + wave * 16384), gw, NGW, lane); for (int it = gw; it < 2 * 24 * 32; it += NGW) adaln_item(PT, it, (float*)(wsp + WS_QKV), lane); }
        if (bx == 0) {
            if (wave == 0 && lane < 2) {
                const float* dl = IN(15) + lane * 256; float a = 0.f, b = 0.f;
                for (int i = 0; i < 64; ++i) { a += dl[i] * dl[64 + i]; b += dl[128 + i] * dl[192 + i]; }
                LAMS[lane] = expf(a) - expf(b) + (0.8f - 0.6f * expf(-0.3f * (float)lane));
            }
            const int tid_l = wave * 64 + lane;
            for (int e = tid_l; e < 64 * 16; e += NWAVES * 64) { const int pos = e >> 4, i = e & 15; const float ang = (float)pos * powf(10000.f, -(float)(2 * i) / 32.f); TAB[e] = cosf(ang); TAB[1024 + e] = sinf(ang); }
            for (int e = tid_l; e < 64 * 8; e += NWAVES * 64) { const int pos = e >> 3, i = e & 7; const float ang = (float)pos * powf(10000.f, -(float)(2 * i) / 16.f); TAB[2048 + e] = cosf(ang); TAB[2560 + e] = sinf(ang); }
        }
    }
    GRID_BAR();
#ifdef MK_EXTRA_BARS
    for (int eb_ = 0; eb_ < MK_EXTRA_BARS; ++eb_) { unsigned char* wsb = ws; asm volatile("" : "+s"(wsb)); int wvb = wave0; asm volatile("" : "+s"(wvb)); XcdBarrier bar_; bar_.bar = (unsigned*)(wsb + WS_CTL) + CW_BAR; bar_.x = xb_xcc_id(); bar_.st = MISC + 8; int lnb; asm volatile("v_mbcnt_lo_u32_b32 %0, -1, 0\n\tv_mbcnt_hi_u32_b32 %0, -1, %0" : "=v"(lnb)); xcd_barrier(bar_, (wvb == 0) && (lnb == 0)); }
#endif
    { PH_BEGIN();
      const float* part = (const float*)(wsp + WS_QKV); const float* bias = IN(5);
      for (int e = gw * 64 + lane; e < 2 * 5 * 6144; e += NGW * 64) { const int l = e / (5 * 6144), r = e - l * 5 * 6144, c = r / 6144, n = r - c * 6144;
          float s = *(const GAS float*)(bias + l * 6144 + n);
          for (int kc = 0; kc < 32; ++kc) s += *(const GAS float*)(part + (((size_t)l * 32 + kc) * 5 + c) * 6144 + n);
          *(GAS float*)(MODS + e) = s; } }
    GRID_BAR();
    { PH_BEGIN();
    for (int row = gw; row < MALL; row += NGW) {
        const bool lat = row < MLAT; const float* xr = lat ? IN(0) + (size_t)row * DM : IN(2) + (size_t)(row - MLAT) * DM;
        const float* md = MODS + (size_t)(lat ? (row >> 12) : 4) * 6144;
        f32x4 x[4];
#pragma unroll
        for (int j = 0; j < 4; ++j) x[j] = *(const GAS f32x4*)(xr + 4 * lane + 256 * j);
        row_prenorm(x, IN(6), md, md + DM, Hb + (size_t)row * DM, lane);
    } }
    GRID_BAR();

    for (int l = 0; l < 2; ++l) {
        const bool last = (l == 1);
        const int npan = last ? PAN_LAT : PAN_ALL;
        const float lam_init = 0.8f - 0.6f * expf(-0.3f * (float)l);
        {
            PH_BEGIN();
            pg8::Gemm g{Hb, (const bf16*)(wsW + W_IN), DM};
            pg8::Sched S{PAN_LAT, 12, 4, last ? 7 : 12, 0, 0, PAN_LAT, 0, PAN_LAT, 1, 0, 0, G, bx};
            pg8::EpiP1 E{CKV, CQ, KR, DK, DV, SK, SV, DQ, SQ, SSKV, SSQ, TAB, 0.125f * LOG2E};
#ifndef MK_NO_P1
#ifndef MK_REP_P1
#define MK_REP_P1 1
#endif
            for (int r_ = 0; r_ < MK_REP_P1; ++r_)
            pg8::gemm_phase<pg8::EpiP1, pg8::Sched, MK_ALIGN, true>(lds, g, S, E, wave, lane);
#endif
        }
        GRID_BAR();
        {
            PH_BEGIN();
            pg8::Gemm g{CKV, (const bf16*)(wsW + W_UKVQ), 256};
            pg8::Sched S{PAN_ALL, 4, npan, 3, 0, 0, PAN_ALL, 4, 0, 1, 0, 0, G, bx};
            pg8::EpiP2 E{MK, MV, QN, QR, SSKV, SSQ, TAB, 0.10206207261596575f * LOG2E, EPS};
#ifndef MK_NO_P2
#ifndef MK_REP_P2
#define MK_REP_P2 1
#endif
            for (int r_ = 0; r_ < MK_REP_P2; ++r_)
            pg8::gemm_phase<pg8::EpiP2, pg8::Sched, MK_ALIGN, true>(lds, g, S, E, wave, lane);
#endif
        }
        GRID_BAR();
        {
            PH_BEGIN();
#ifdef MK_ATT_OUT_DOUT
            bf16* OAd = (bf16*)OUTP; att::Bufs B{QN, QR, MK, MV, KR, DQ, DK, DV, SQ, SK, SV, OAd, OAd + (size_t)MALL * 512, OAd + 2 * (size_t)MALL * 512, 0, (unsigned*)(wsp + 239 * MiB) + (size_t)bx * 16384, LAMS + l, IN(16) + l * 128, IN(17) + l * 8, lam_init, EPS};
#else
            att::Bufs B{QN, QR, MK, MV, KR, DQ, DK, DV, SQ, SK, SV, QN, DQ, SQ, 0, (unsigned*)(wsp + 239 * MiB) + (size_t)bx * 16384, LAMS + l, IN(16) + l * 128, IN(17) + l * 8, lam_init, EPS};
#endif
            LAS unsigned char* al = lds;
#ifdef MK_ATT_TWICE
#define ATT_UNIT(...) do { if (B.dry) att::attn_unit<ATT_PROBE>(__VA_ARGS__); else att::attn_unit<0>(__VA_ARGS__); } while (0)
            for (int rep_ = 0; rep_ < 2; ++rep_) { B.dry = (rep_ == 0);
#else
#define ATT_UNIT(...) att::attn_unit<0>(__VA_ARGS__)
#endif
#ifndef MK_NO_DIFF
            for (int u = vcu; u < 256; u += G) ATT_UNIT(al, B, 1, u >> 6, (u >> 4) & 3, u & 15, wave, lane);
#endif
#ifndef MK_NO_MLA
            for (int u = vcu; u < 512; u += G) ATT_UNIT(al, B, 0, u >> 7, (u >> 4) & 7, u & 15, wave, lane);
#endif
#ifndef MK_NO_SWA
            for (int u = vcu; u < 512; u += G) ATT_UNIT(al, B, 2, u >> 7, (u >> 4) & 7, u & 15, wave, lane);
#endif
            if (!last) {
#ifndef MK_NO_CTXQ
                for (int u = vcu; u < 80; u += G) {
                    if (u < 32) ATT_UNIT(al, B, 0, u >> 3, u & 7, 16, wave, lane);
                    else if (u < 48) ATT_UNIT(al, B, 1, (u - 32) >> 2, (u - 32) & 3, 16, wave, lane);
                    else ATT_UNIT(al, B, 2, (u - 48) >> 3, (u - 48) & 7, 16, wave, lane);
                }
#endif
            }
#ifdef MK_ATT_TWICE
            }
#endif
        }
        GRID_BAR();
        {
            PH_BEGIN();
            pg8::Gemm g{Hb, (const bf16*)(wsW + W_G), DM};
            pg8::Sched S{npan, 12, 0, 0, 0, 0, 0, 0, 0, 1, 0, 0, G, bx};
            pg8::EpiSig E{GT};
#ifndef MK_NO_P3B
#ifndef MK_REP_P3B
#define MK_REP_P3B 1
#endif
            for (int r_ = 0; r_ < MK_REP_P3B; ++r_)
            pg8::gemm_phase<pg8::EpiSig, pg8::Sched, MK_ALIGN, true>(lds, g, S, E, wave, lane);
#endif
        }
        GRID_BAR();
        {
            PH_BEGIN();
            pg8::Gemm g{QN, (const bf16*)(wsW + W_ABC), 512};
            pg8::Sched S{npan, 4, 0, 0, 0, 0, 0, 0, 0, 3, PAN_ALL, 4, G, bx};
            pg8::EpiMerge E{GT, Hb};
#ifndef MK_NO_P4A
#ifndef MK_REP_P4A
#define MK_REP_P4A 1
#endif
            for (int r_ = 0; r_ < MK_REP_P4A; ++r_)
            pg8::gemm_phase<pg8::EpiMerge, pg8::Sched, MK_ALIGN, true>(lds, g, S, E, wave, lane);
#endif
        }
        GRID_BAR();
        {
            PH_BEGIN();
            pg8::Gemm g{Hb, (const bf16*)(wsW + W_O), DM};
            pg8::Sched S{npan, 4, 0, 0, 0, 0, 0, 0, 0, 1, 0, 0, G, bx};
            pg8::EpiF32 E{Yb, DM};
#ifndef MK_NO_PF32
#ifndef MK_REP_P4B
#define MK_REP_P4B 1
#endif
            for (int r_ = 0; r_ < MK_REP_P4B; ++r_)
            pg8::gemm_phase<pg8::EpiF32, pg8::Sched, MK_ALIGN, true>(lds, g, S, E, wave, lane);
#endif
        }
        GRID_BAR();
        { PH_BEGIN(); const float* mods_l = MODS + (size_t)l * 5 * 6144;
        for (int row = gw; row < npan * 256; row += NGW) {
            const bool lat = row < MLAT; const float* md = mods_l + (size_t)(lat ? (row >> 12) : 4) * 6144;
            const float* res = lat ? ((l == 0 ? IN(0) : (const float*)OUTP) + (size_t)row * DM) : ((l == 0 ? IN(2) : (const float*)CTXRES) + (size_t)(row - MLAT) * DM);
            float* ro = lat ? OUTP + (size_t)row * DM : CTXRES + (size_t)(row - MLAT) * DM;
            row_post(res, Yb + (size_t)row * DM, IN(7) + l * DM, md + 2 * DM, ro, IN(8) + l * DM, md + 3 * DM, md + 4 * DM, Hb + (size_t)row * DM, lane);
        } }
        GRID_BAR();
        {
            PH_BEGIN();
            pg8::Gemm g{Hb, (const bf16*)(wsW + W_GU), DM};
            pg8::Sched S{npan, 22, 0, 0, 0, 0, 0, 0, 0, 1, 0, 0, G, bx};
            pg8::EpiSwiglu E{ACT};
#ifndef MK_NO_P5
#ifndef MK_REP_P5
#define MK_REP_P5 1
#endif
            for (int r_ = 0; r_ < MK_REP_P5; ++r_)
            pg8::gemm_phase<pg8::EpiSwiglu, pg8::Sched, MK_ALIGN, true>(lds, g, S, E, wave, lane);
#endif
        }
        GRID_BAR();
        {
            PH_BEGIN();
            pg8::Gemm g{ACT, (const bf16*)(wsW + W_DN), DFF};
            pg8::Sched S{npan, 4, 0, 0, 0, 0, 0, 0, 0, 1, 0, 0, G, bx};
            pg8::EpiF32 E{F2, DM};
#ifndef MK_NO_PF32
#ifndef MK_REP_P6
#define MK_REP_P6 1
#endif
            for (int r_ = 0; r_ < MK_REP_P6; ++r_)
            pg8::gemm_phase<pg8::EpiF32, pg8::Sched, MK_ALIGN, true>(lds, g, S, E, wave, lane);
            if (!last && bx >= 16 && G == 256) convert_weights(PT, 1, wsW, (LAS float*)(lds + wave * 16384), (bx - 16) * NWAVES + wave, 240 * NWAVES, lane, 1);
#endif
        }
        GRID_BAR();
        {
            PH_BEGIN(); const float* mods_l = MODS + (size_t)l * 5 * 6144;
            const float* mods_n = MODS + (size_t)(l + 1) * 5 * 6144;
            for (int row = gw; row < npan * 256; row += NGW) {
                const bool lat = row < MLAT; const int cond = lat ? (row >> 12) : 4; const float* md = mods_l + (size_t)cond * 6144; const float* mn = mods_n + (size_t)cond * 6144;
                float* ro = lat ? OUTP + (size_t)row * DM : CTXRES + (size_t)(row - MLAT) * DM;
                row_post(ro, F2 + (size_t)row * DM, IN(9) + l * DM, md + 5 * DM, ro, IN(6) + (l + 1) * DM, mn, mn + DM, last ? nullptr : Hb + (size_t)row * DM, lane);
            }
            if (!last) convert_weights(PT, l + 1, wsW, (LAS float*)(lds + wave * 16384), gw, NGW, lane, (G == 256) ? 2 : 0);
        }
        if (!last) GRID_BAR();
    }
    if (false) {
dump_and_exit:
#ifdef MK_DUMP_LO
        { unsigned char* wsd = ws; asm volatile("" : "+s"(wsd)); int ln; asm volatile("v_mbcnt_lo_u32_b32 %0, -1, 0\n\tv_mbcnt_hi_u32_b32 %0, -1, %0" : "=v"(ln));
          const unsigned* src = (const unsigned*)(wsd + (size_t)(MK_DUMP_LO)); const size_t nw = ((size_t)(MK_DUMP_HI) - (size_t)(MK_DUMP_LO)) / 4; float* o = OUTP;
          const size_t NO = (size_t)MLAT * DM;
          if (nw > 0) for (size_t j = (size_t)bx * 512 + wave0 * 64 + ln; j < NO; j += (size_t)G * 512) { unsigned x = 0u; for (size_t q = j; q < nw; q += NO) x ^= src[q]; x ^= x >> 16; o[j] = (float)(x & 0xffffu) * (1.0f / 65536.0f); } }
#endif
        return;
    }
    { unsigned char* wsb = ws; asm volatile("" : "+s"(wsb)); const unsigned tmo = __hip_atomic_load((unsigned*)(wsb + WS_CTL) + CW_BAR + XB_TMO, __ATOMIC_RELAXED, __HIP_MEMORY_SCOPE_AGENT);
      if (tmo != 0u && bx == 0 && wave0 == 0) { float* o = OUTP; o[0] = 3.0e7f; } }
}

extern "C" void kernel_launch(void* const* d_in, const int* in_sizes, int n_in, void* d_out, int out_size, void* d_ws, size_t ws_size, hipStream_t stream) {
    static int grid = 0;
    if (grid == 0) {
        if (n_in != 24 || out_size != MLAT * DM || ws_size < 255 * MiB) { fprintf(stderr, "kernel_launch: unexpected shapes (n_in %d out %d ws %zu need %zu)\n", n_in, out_size, ws_size, (size_t)WS_END); grid = -1; return; }
        int dev = 0, cus = 0, per_cu = 0;
        (void)hipGetDevice(&dev); (void)hipDeviceGetAttribute(&cus, hipDeviceAttributeMultiprocessorCount, dev);
        if (hipFuncSetAttribute((const void*)mk_fwd, hipFuncAttributeMaxDynamicSharedMemorySize, LDS_BYTES) != hipSuccess) { fprintf(stderr, "kernel_launch: hipFuncSetAttribute failed\n"); grid = -1; return; }
        (void)hipOccupancyMaxActiveBlocksPerMultiprocessor(&per_cu, (const void*)mk_fwd, NWAVES * 64, LDS_BYTES);
        (void)hipGetLastError();
        if (per_cu < 1) fprintf(stderr, "kernel_launch: occupancy query says %d blocks/CU\n", per_cu);
        grid = cus;
    }
    if (grid < 0) return;
    (void)hipMemsetAsync((char*)d_ws + WS_CTL, 0, CTL_BYTES, stream);
    Ptrs p{};
    for (int i = 0; i < 24; ++i) p.in[i] = (const float*)d_in[i];
    p.out = (float*)d_out; p.ws = (unsigned char*)d_ws;
    hipLaunchKernelGGL(mk_fwd, dim3(grid), dim3(NWAVES * 64), LDS_BYTES, stream, p);
#ifdef MK_CHECK
    {
#ifndef MK_CHECK_LAYER
#define MK_CHECK_LAYER 0
#endif
#ifndef MK_CHECK_SLOT
#define MK_CHECK_SLOT 0
#endif
        constexpr int L = MK_CHECK_LAYER; unsigned char* ws = (unsigned char*)d_ws;
        float* err = (float*)(ws + 255 * MiB + 524288); const float** tab = (const float**)(ws + 255 * MiB + 524288 + 4096); float* Z = (float*)d_out;
        const float* w_in = (const float*)d_in[10] + (size_t)L * DM * INW;
        chk::set_tab<<<1, 32, 0, stream>>>(p, tab); chk::zero_err<<<1, 64, 0, stream>>>(err);
#if MK_CHECK == 1
        chk::gemm_rows<<<dim3(24, chk::NS), 256, 0, stream>>>((const unsigned short*)(ws + WS_H), 1024, 1024, w_in, INW, INW, Z, INW);
        chk::cmp_p1<<<dim3(12, chk::NS), 256, 0, stream>>>(Z, ws, err); chk::cmp_ss<<<chk::NS, 64, 0, stream>>>(Z, ws, err + 2);
#elif MK_CHECK == 2
        chk::cmp_p2<<<dim3(7, chk::NS), 256, 0, stream>>>(tab, ws, err);
#elif MK_CHECK == 3
        chk::cmp_attn<<<dim3(chk::NS, 8, 3), 64, 0, stream>>>(tab, ws, (const unsigned short*)d_out, L, err);
#elif MK_CHECK == 4
        chk::gemm_rows<<<dim3(12, chk::NS), 256, 0, stream>>>((const unsigned short*)(ws + WS_H), 1024, 1024, w_in + 2848, INW, 3072, Z, 3072);
        chk::cmp_gates<<<dim3(12, chk::NS), 256, 0, stream>>>(Z, ws, err);
#elif MK_CHECK == 5
        chk::cmp_merge<<<dim3(4, chk::NS), 256, 0, stream>>>(tab, ws, L, err);
#elif MK_CHECK == 6
        chk::gemm_rows<<<dim3(4, chk::NS), 256, 0, stream>>>((const unsigned short*)(ws + WS_H), 1024, 1024, (const float*)d_in[21] + (size_t)L * DM * DM, DM, DM, Z, DM);
        chk::cmp_f32<<<dim3(4, chk::NS), 256, 0, stream>>>(Z, DM, (const float*)(ws + Q_Y), DM, DM, err);
#elif MK_CHECK == 7
        chk::cmp_rowpost<<<chk::NS, 256, 0, stream>>>(tab, ws, (const float*)d_out, L, 1, err);
#elif MK_CHECK == 8
        chk::gemm_rows<<<dim3(22, chk::NS), 256, 0, stream>>>((const unsigned short*)(ws + WS_H), 1024, 1024, (const float*)d_in[22] + (size_t)L * DM * 2 * DFF, 2 * DFF, 2 * DFF, Z, 2 * DFF);
        chk::cmp_act<<<dim3(11, chk::NS), 256, 0, stream>>>(Z, ws, err);
#elif MK_CHECK == 9
        chk::gemm_rows<<<dim3(4, chk::NS), 256, 0, stream>>>((const unsigned short*)(ws + Q_ACT), DFF, DFF, (const float*)d_in[23] + (size_t)L * DFF * DM, DM, DM, Z, DM);
        chk::cmp_f32<<<dim3(4, chk::NS), 256, 0, stream>>>(Z, DM, (const float*)(ws + Q_F2), DM, DM, err);
#endif
        chk::encode<<<1024, 256, 0, stream>>>(err, (float*)d_out, (size_t)MLAT * DM, MK_CHECK_SLOT);
    }
#endif
}
```
